# Optimizing an MI355X kernel written in HIP

```python
import jax, jax.numpy as jnp
from jax import lax
import numpy as np

D_MODEL = 2048
BATCH = 16
SEQ = 2048
DEPTH = 1

CHUNK = 64
Q_BLOCK = 128
N_MEM = 256
EPS = 1e-6

D_FF = 5504

MLA_HEADS = 8
QK_NOPE = 128
QK_ROPE = 64
V_HEAD = 128
Q_LORA = 512
KV_LORA = 256
ROPE_THETA = 10000.0

RWKV_HEADS = 16
RWKV_HEAD = 64
RWKV_WIDTH = RWKV_HEADS * RWKV_HEAD
DECAY_LORA = 64
A_LORA = 64
GATE_LORA = 128
LNX_EPS = 64e-5

MEM_HEADS = 4
MEM_HEAD = 256

N_BRANCH = 2
MLA_COLS = Q_LORA + KV_LORA + QK_ROPE
RWKV_COLS = 3 * RWKV_WIDTH + DECAY_LORA + A_LORA + GATE_LORA
GATE_COLS = N_BRANCH * D_MODEL
IN_COLS = MLA_COLS + RWKV_COLS + GATE_COLS

kernel_name = 'hybrid_mla_rwkv7_gated_macaron_layer'


def rmsnorm(x, g, eps=EPS):
    xf = x.astype(jnp.float32)
    y = xf * lax.rsqrt(jnp.mean(xf * xf, axis=-1, keepdims=True) + eps)
    return (y * g.astype(jnp.float32)).astype(x.dtype)


def apply_rope(x, positions):
    half = x.shape[-1] // 2
    inv = ROPE_THETA ** (-jnp.arange(half, dtype=jnp.float32) / half)
    ang = positions.astype(jnp.float32)[..., None] * inv
    if x.ndim == 4:
        ang = ang[:, :, None, :]
    cos, sin = jnp.cos(ang), jnp.sin(ang)
    xf = x.astype(jnp.float32)
    x1, x2 = xf[..., :half], xf[..., half:]
    return jnp.concatenate([x1 * cos - x2 * sin, x1 * sin + x2 * cos], axis=-1).astype(x.dtype)


def swiglu(h, w_gate, w_up, w_down):
    return (jax.nn.silu(h @ w_gate) * (h @ w_up)) @ w_down


def mla_branch(c_q, c_kv, k_rope, positions, n_q_lat, w_uq, n_kv_lat, w_ukv, w_oa):
    B, S, _ = c_q.shape
    q = (rmsnorm(c_q, n_q_lat) @ w_uq).reshape(B, S, MLA_HEADS, QK_NOPE + QK_ROPE)
    q_nope = q[..., :QK_NOPE]
    q_rope = apply_rope(q[..., QK_NOPE:], positions)
    kv = (rmsnorm(c_kv, n_kv_lat) @ w_ukv).reshape(B, S, MLA_HEADS, QK_NOPE + V_HEAD)
    k_nope, v = kv[..., :QK_NOPE], kv[..., QK_NOPE:]
    k_r = apply_rope(k_rope, positions)
    scale = (QK_NOPE + QK_ROPE) ** -0.5
    outs = []
    for qb in range(S // Q_BLOCK):
        qs, qe = qb * Q_BLOCK, (qb + 1) * Q_BLOCK
        s = (jnp.einsum('bqhd,bkhd->bhqk', q_nope[:, qs:qe], k_nope[:, :qe])
             + jnp.einsum('bqhd,bkd->bhqk', q_rope[:, qs:qe], k_r[:, :qe]))
        s = s.astype(jnp.float32) * scale
        q_chunk = (qs + jnp.arange(Q_BLOCK)) // CHUNK
        k_chunk = jnp.arange(qe) // CHUNK
        mask = k_chunk[None, :] <= q_chunk[:, None]
        s = jnp.where(mask[None, None], s, -jnp.inf)
        p = jax.nn.softmax(s, axis=-1).astype(v.dtype)
        outs.append(jnp.einsum('bhqk,bkhd->bqhd', p, v[:, :qe]))
    o = jnp.concatenate(outs, axis=1).reshape(B, S, MLA_HEADS * V_HEAD)
    return o @ w_oa


def token_shift(y, mu):
    y_prev = jnp.pad(y, ((0, 0), (1, 0), (0, 0)))[:, :-1]
    return y + (y_prev - y) * mu


def rwkv7_branch(proj, mu_shift, w0, w_w2, a0, w_a2, w_g2, k_k, k_a, r_k, lnx_w, lnx_b, w_ob):
    B, S, _ = proj.shape
    C, H, N = RWKV_WIDTH, RWKV_HEADS, RWKV_HEAD
    p = token_shift(proj, mu_shift)
    r, k, v, dw, da, dg = jnp.split(
        p, [C, 2 * C, 3 * C, 3 * C + DECAY_LORA, 3 * C + DECAY_LORA + A_LORA], axis=-1)
    w = -jax.nn.softplus(-(w0 + jnp.tanh(dw) @ w_w2)) - 0.5
    decay = jnp.exp(-jnp.exp(w.astype(jnp.float32)))
    a = jax.nn.sigmoid(a0 + da @ w_a2)
    g = jax.nn.sigmoid(dg) @ w_g2
    kk = (k * k_k).reshape(B, S, H, N).astype(jnp.float32)
    kk = kk / jnp.maximum(jnp.sqrt(jnp.sum(kk * kk, axis=-1, keepdims=True)), 1e-12)
    k = k * (1.0 + (a - 1.0) * k_a)
    heads = lambda t: t.reshape(B, S, H, N).astype(jnp.float32)
    rh, kh, vh, ah, wh = heads(r), heads(k), heads(v), heads(a), heads(decay)
    a_in = -kk
    b_in = kk * ah
    xs = tuple(jnp.moveaxis(t, 1, 0) for t in (rh, wh, kh, vh, a_in, b_in))

    def step(state, inp):
        r_t, w_t, k_t, v_t, a_t, b_t = inp
        sa = jnp.einsum('bhvk,bhk->bhv', state, a_t)
        state = (state * w_t[:, :, None, :] + sa[..., None] * b_t[:, :, None, :]
                 + v_t[..., None] * k_t[:, :, None, :])
        return state, jnp.einsum('bhvk,bhk->bhv', state, r_t)

    s0 = jnp.zeros((B, H, N, N), jnp.float32)
    _, o = lax.scan(step, s0, xs)
    o = jnp.moveaxis(o, 0, 1)
    mean = jnp.mean(o, axis=-1, keepdims=True)
    var = jnp.mean(jnp.square(o - mean), axis=-1, keepdims=True)
    o = ((o - mean) * lax.rsqrt(var + LNX_EPS)).reshape(B, S, C)
    o = o * lnx_w.astype(jnp.float32) + lnx_b.astype(jnp.float32)
    bonus = jnp.sum(rh * kh * r_k.astype(jnp.float32), axis=-1, keepdims=True) * vh
    o = (o + bonus.reshape(B, S, C)).astype(proj.dtype)
    return (o * g) @ w_ob


def memory_xattn(h, mem, n_mem, w_cq, w_ckv, w_co):
    B, S, _ = h.shape
    M = mem.shape[1]
    q = (h @ w_cq).reshape(B, S, MEM_HEADS, MEM_HEAD)
    kv = (rmsnorm(mem, n_mem) @ w_ckv).reshape(B, M, MEM_HEADS, 2 * MEM_HEAD)
    k, v = kv[..., :MEM_HEAD], kv[..., MEM_HEAD:]
    s = jnp.einsum('bqhd,bmhd->bhqm', q, k).astype(jnp.float32) * (MEM_HEAD ** -0.5)
    p = jax.nn.softmax(s, axis=-1).astype(v.dtype)
    o = jnp.einsum('bhqm,bmhd->bqhd', p, v).reshape(B, S, MEM_HEADS * MEM_HEAD)
    return o @ w_co


def setup_inputs(seed: int = 0) -> dict:
    key = jax.random.key(seed)
    ks = iter(jax.random.split(key, 64))
    f32 = jnp.float32
    L, D = DEPTH, D_MODEL

    def nrm(shape, scale):
        return jax.random.normal(next(ks), shape, f32) * scale

    def gain(shape):
        return 1.0 + nrm(shape, 0.05)

    def dense(shape):
        return nrm(shape, shape[-2] ** -0.5)

    x = nrm((BATCH, SEQ, D), 1.0)
    mem = nrm((BATCH, N_MEM, D), 1.0)
    offset = jax.random.randint(next(ks), (BATCH, 1), 0, 4096, jnp.int32)
    positions = offset + jnp.arange(SEQ, dtype=jnp.int32)[None, :]
    return {
        'x': x, 'mem': mem, 'positions': positions,
        'n_ffn1_pre': gain((L, D)), 'n_ffn1_post': gain((L, D)),
        'w_ffn1_gate': dense((L, D, D_FF)), 'w_ffn1_up': dense((L, D, D_FF)),
        'w_ffn1_down': dense((L, D_FF, D)),
        'n_mix_pre': gain((L, D)), 'n_mix_post': gain((L, D)),
        'w_in': dense((L, D, IN_COLS)), 'b_gate': nrm((L, GATE_COLS), 0.02),
        'n_q_lat': gain((L, Q_LORA)), 'w_uq': dense((L, Q_LORA, MLA_HEADS * (QK_NOPE + QK_ROPE))),
        'n_kv_lat': gain((L, KV_LORA)), 'w_ukv': dense((L, KV_LORA, MLA_HEADS * (QK_NOPE + V_HEAD))),
        'w_oa': dense((L, MLA_HEADS * V_HEAD, D)),
        'mu_shift': jax.random.uniform(next(ks), (L, RWKV_COLS), f32),
        'w0': jax.random.uniform(next(ks), (L, RWKV_WIDTH), f32, -5.0, 0.0),
        'w_w2': nrm((L, DECAY_LORA, RWKV_WIDTH), 0.1 * DECAY_LORA ** -0.5),
        'a0': nrm((L, RWKV_WIDTH), 0.1),
        'w_a2': nrm((L, A_LORA, RWKV_WIDTH), 0.5 * A_LORA ** -0.5),
        'w_g2': dense((L, GATE_LORA, RWKV_WIDTH)),
        'k_k': 0.85 + nrm((L, RWKV_WIDTH), 0.05),
        'k_a': gain((L, RWKV_WIDTH)),
        'r_k': nrm((L, RWKV_HEADS, RWKV_HEAD), 0.1),
        'lnx_w': gain((L, RWKV_WIDTH)), 'lnx_b': nrm((L, RWKV_WIDTH), 0.02),
        'w_ob': dense((L, RWKV_WIDTH, D)),
        'w_o': dense((L, D, D)),
        'n_x_pre': gain((L, D)), 'n_x_post': gain((L, D)), 'n_mem': gain((L, D)),
        'w_cq': dense((L, D, MEM_HEADS * MEM_HEAD)),
        'w_ckv': dense((L, D, 2 * MEM_HEADS * MEM_HEAD)),
        'w_co': dense((L, MEM_HEADS * MEM_HEAD, D)),
        'n_ffn2_pre': gain((L, D)), 'n_ffn2_post': gain((L, D)),
        'w_ffn2_gate': dense((L, D, D_FF)), 'w_ffn2_up': dense((L, D, D_FF)),
        'w_ffn2_down': dense((L, D_FF, D)),
    }


def reference(x, mem, positions,
              n_ffn1_pre, n_ffn1_post, w_ffn1_gate, w_ffn1_up, w_ffn1_down,
              n_mix_pre, n_mix_post, w_in, b_gate,
              n_q_lat, w_uq, n_kv_lat, w_ukv, w_oa,
              mu_shift, w0, w_w2, a0, w_a2, w_g2, k_k, k_a, r_k, lnx_w, lnx_b, w_ob,
              w_o,
              n_x_pre, n_x_post, n_mem, w_cq, w_ckv, w_co,
              n_ffn2_pre, n_ffn2_post, w_ffn2_gate, w_ffn2_up, w_ffn2_down):
    B, S, _ = x.shape
    for l in range(DEPTH):
        h = rmsnorm(x, n_ffn1_pre[l])
        x = x + 0.5 * rmsnorm(swiglu(h, w_ffn1_gate[l], w_ffn1_up[l], w_ffn1_down[l]), n_ffn1_post[l])

        h = rmsnorm(x, n_mix_pre[l])
        proj = h @ w_in[l]
        c_q, c_kv, k_rope, rwkv_in, gate_logits = jnp.split(
            proj, [Q_LORA, Q_LORA + KV_LORA, MLA_COLS, MLA_COLS + RWKV_COLS], axis=-1)
        y_a = mla_branch(c_q, c_kv, k_rope, positions, n_q_lat[l], w_uq[l],
                         n_kv_lat[l], w_ukv[l], w_oa[l])
        y_b = rwkv7_branch(rwkv_in, mu_shift[l], w0[l], w_w2[l], a0[l], w_a2[l], w_g2[l],
                           k_k[l], k_a[l], r_k[l], lnx_w[l], lnx_b[l], w_ob[l])
        gates = jax.nn.sigmoid(gate_logits + b_gate[l]).reshape(B, S, N_BRANCH, D_MODEL)
        merged = gates[:, :, 0] * y_a + gates[:, :, 1] * y_b
        x = x + rmsnorm(merged @ w_o[l], n_mix_post[l])

        h = rmsnorm(x, n_x_pre[l])
        x = x + rmsnorm(memory_xattn(h, mem, n_mem[l], w_cq[l], w_ckv[l], w_co[l]), n_x_post[l])

        h = rmsnorm(x, n_ffn2_pre[l])
        x = x + 0.5 * rmsnorm(swiglu(h, w_ffn2_gate[l], w_ffn2_up[l], w_ffn2_down[l]), n_ffn2_post[l])
    return x
```

```cpp
#include <hip/hip_runtime.h>
#include <hip/hip_cooperative_groups.h>
#include <cstdio>
namespace cg = cooperative_groups;


#define DEVINL __device__ __forceinline__
#define LAS __attribute__((address_space(3)))
typedef unsigned short bf16_t;
typedef short bf16x8 __attribute__((ext_vector_type(8)));
typedef float f32x4 __attribute__((ext_vector_type(4)));
typedef float f32x2 __attribute__((ext_vector_type(2)));
typedef unsigned u32x4 __attribute__((ext_vector_type(4)));
typedef unsigned u32x2 __attribute__((ext_vector_type(2)));

constexpr int T = 32768, D = 2048, DFF = 5504, SEQ = 2048, NB = 16, NMEMT = 4096;
constexpr int LDS_BYTES = 147456;

constexpr size_t MiB = 1048576;
constexpr size_t OFF_WIN = 0;
constexpr size_t OFF_WUQ = OFF_WIN + (size_t)8448 * 2048 * 2;
constexpr size_t OFF_WUKVK = OFF_WUQ + (size_t)1536 * 512 * 2;
constexpr size_t OFF_WUKVV = OFF_WUKVK + (size_t)1024 * 256 * 2;
constexpr size_t OFF_WLORA = OFF_WUKVV + (size_t)1024 * 256 * 2;
constexpr size_t OFF_WOA = OFF_WLORA + (size_t)3072 * 256 * 2;
constexpr size_t OFF_WOB = OFF_WOA + (size_t)2048 * 1024 * 2;
constexpr size_t OFF_WO = OFF_WOB + (size_t)2048 * 1024 * 2;
constexpr size_t OFF_WCQ = OFF_WO + (size_t)2048 * 2048 * 2;
constexpr size_t OFF_WCKVK = OFF_WCQ + (size_t)1024 * 2048 * 2;
constexpr size_t OFF_WCKVV = OFF_WCKVK + (size_t)1024 * 2048 * 2;
constexpr size_t OFF_WCO = OFF_WCKVV + (size_t)1024 * 2048 * 2;
constexpr size_t OFF_WFFGU = OFF_WCO + (size_t)2048 * 1024 * 2;
constexpr size_t OFF_WFFD = OFF_WFFGU + (size_t)11008 * 2048 * 2;
constexpr size_t OFF_KMEM = OFF_WFFD + (size_t)2048 * 5504 * 2;
constexpr size_t OFF_VTMEM = OFF_KMEM + (size_t)4096 * 1024 * 2;
constexpr size_t OFF_KR = OFF_VTMEM + (size_t)1024 * 4096 * 2;
constexpr size_t OFF_CS = OFF_KR + (size_t)T * 64 * 2;
constexpr size_t OFF_DYN = ((OFF_CS + (size_t)T * 32 * 8) + MiB - 1) / MiB * MiB;
constexpr size_t DY_H = OFF_DYN + 0 * MiB;
constexpr size_t DY_ACT = OFF_DYN + 128 * MiB;
constexpr size_t DY_YFFN = OFF_DYN + 472 * MiB;
constexpr size_t DY_MEMN = OFF_DYN + 728 * MiB;
constexpr size_t DY_GATES = OFF_DYN + 128 * MiB;
constexpr size_t DY_PRWKV = OFF_DYN + 384 * MiB;
constexpr size_t DY_PMLA = OFF_DYN + 592 * MiB;
constexpr size_t DY_LIN = OFF_DYN + 640 * MiB;
constexpr size_t DY_Q = OFF_DYN + 0 * MiB;
constexpr size_t DY_KN = OFF_DYN + 656 * MiB;
constexpr size_t DY_VT = OFF_DYN + 720 * MiB;
constexpr size_t DY_OMLA = OFF_DYN + 784 * MiB;
constexpr size_t DY_KRRAW = OFF_DYN + 848 * MiB;
constexpr size_t DY_A = OFF_DYN + 0 * MiB;
constexpr size_t DY_G = OFF_DYN + 64 * MiB;
constexpr size_t DY_U = OFF_DYN + 656 * MiB;
constexpr size_t DY_ORWKV = OFF_DYN + 720 * MiB;
constexpr size_t DY_MERGED = OFF_DYN + 384 * MiB;
constexpr size_t DY_Y = OFF_DYN + 128 * MiB;
constexpr size_t DY_QX = OFF_DYN + 512 * MiB;
constexpr size_t DY_OX = OFF_DYN + 576 * MiB;
constexpr size_t OFF_BAR = OFF_DYN + 856 * MiB;
constexpr size_t WS_NEED = OFF_BAR + 65536;

struct ConvJob { const float* src; bf16_t* dst; int K, ldn, c0, ncols, gs, sstride, dstride, ldk; };
constexpr int NJOBS = 23;
struct Params {
    const float* in[41];
    const int* pos;
    float* out;
    unsigned char* ws;
    ConvJob jobs[NJOBS];
};

typedef __bf16 bf16x2_t __attribute__((ext_vector_type(2)));
DEVINL unsigned cvt_pk_bf16(float lo, float hi) { const f32x2 v = {lo, hi}; return __builtin_bit_cast(unsigned, __builtin_convertvector(v, bf16x2_t)); }
DEVINL int opaque_tid() { int t = threadIdx.x; asm volatile("" : "+v"(t)); return t; }
DEVINL float bflo(unsigned w) { return __uint_as_float(w << 16); }
DEVINL float bfhi(unsigned w) { return __uint_as_float(w & 0xffff0000u); }
DEVINL float wave_sum(float v) {
#pragma unroll
    for (int o = 32; o >= 1; o >>= 1) v += __shfl_xor(v, o);
    return v;
}
DEVINL float sigmoidf_(float z) { return __builtin_amdgcn_rcpf(1.0f + __expf(-z)); }
DEVINL void store8(bf16_t* p, f32x4 v0, f32x4 v1) {
    u32x4 w; w.x = cvt_pk_bf16(v0[0], v0[1]); w.y = cvt_pk_bf16(v0[2], v0[3]); w.z = cvt_pk_bf16(v1[0], v1[1]); w.w = cvt_pk_bf16(v1[2], v1[3]);
    *(u32x4*)p = w;
}
DEVINL void store8_nt(bf16_t* p, f32x4 v0, f32x4 v1) {
    u32x4 w; w.x = cvt_pk_bf16(v0[0], v0[1]); w.y = cvt_pk_bf16(v0[2], v0[3]); w.z = cvt_pk_bf16(v1[0], v1[1]); w.w = cvt_pk_bf16(v1[2], v1[3]);
    __builtin_nontemporal_store(w, (u32x4*)p);
}
DEVINL void unpack8(u32x4 w, float (&f)[8]) {
    f[0] = bflo(w.x); f[1] = bfhi(w.x); f[2] = bflo(w.y); f[3] = bfhi(w.y); f[4] = bflo(w.z); f[5] = bfhi(w.z); f[6] = bflo(w.w); f[7] = bfhi(w.w);
}
template <int CTRL> DEVINL float dppf(float x) { return __int_as_float(__builtin_amdgcn_update_dpp(0, __float_as_int(x), CTRL, 0xF, 0xF, true)); }
DEVINL float sum8(float v) { v += dppf<0xB1>(v); v += dppf<0x4E>(v); v += dppf<0x141>(v); return v; }

constexpr int BM = 256, BK = 64, HALF = 128, HTB = HALF * BK * 2, NXCD = 8, WGM = 8;
__host__ __device__ __forceinline__ int lds_byte(int r, int c) { const int st = (r >> 4) * 2 + (c >> 5), rr = r & 15, cc = c & 31, ob = rr * 64 + cc * 2; return st * 1024 + (ob ^ (((ob >> 9) & 1) << 5)); }
__host__ __device__ __forceinline__ void stage_rc(int b, int& R, int& C) { const int st = b / 1024, sb = b % 1024, swz = sb ^ (((sb >> 9) & 1) << 5); R = (st >> 1) * 16 + swz / 64; C = (st & 1) * 32 + (swz % 64) / 2; }
__host__ __device__ __forceinline__ int perm32(int rho) { const int n = rho >> 4, i = rho & 15; return 8 * (i >> 2) + 4 * n + (i & 3); }

struct Unit { int pm, pn; };
struct Gemm { const bf16_t* A; const bf16_t* Bt; int M, N, K, lda, ldb; };

struct Order {
    int nM, nN, nwg, G, c;
    DEVINL void init(int M, int N, int G_, int c_) { nM = M / BM; nN = N / BM; nwg = nM * nN; G = G_; c = c_; }
    DEVINL bool next(int i, Unit& u) const {
        const long L = (long)i * G + c; if (L >= nwg) return false;
        int wgid = (int)L; { const int q = nwg / NXCD, r = nwg % NXCD, xcd = wgid % NXCD, off = wgid / NXCD; wgid = (xcd < r ? xcd * (q + 1) : r * (q + 1) + (xcd - r) * q) + off; }
        const int nig = WGM * nN, gid = wgid / nig, fm = gid * WGM, gsz = (nM - fm) < WGM ? (nM - fm) : WGM;
        u.pm = fm + ((wgid % nig) % gsz); u.pn = (wgid % nig) / gsz; return true;
    }
};

template <class Epi>
DEVINL void gemm_phase(LAS unsigned char* lds, const Gemm g, const Order& S, const Epi& E) {
    const int tid = opaque_tid(), wid = __builtin_amdgcn_readfirstlane(tid >> 6), lane = tid & 63, wr = wid >> 2, wc = wid & 3, fr = lane & 15, fq = lane >> 4;
    const int K = g.K, nt = K / BK;
    unsigned voffA[2], voffB[2];
#pragma unroll
    for (int i = 0; i < 2; ++i) { int R, C; stage_rc(tid * 16 + i * 8192, R, C); const int Rb = Epi::PERM ? ((R & ~31) + perm32(R & 31)) : R;
        voffA[i] = (unsigned)(R * g.lda + C) * 2u; voffB[i] = (unsigned)(Rb * g.ldb + C) * 2u; }
    const size_t kstep = (size_t)(BK * 2);
    const size_t hstepA = (size_t)HALF * g.lda * 2, hstepB = (size_t)HALF * g.ldb * 2;
    const size_t tstepA = 2 * hstepA, tstepB = 2 * hstepB;
    const unsigned ldsw = (unsigned)wid * 1024u;
    const int aoff = lds_byte(wr * 64 + fr, fq * 8), boff = lds_byte(wc * 32 + fr, fq * 8);
#define PG8_SA(b, h) (((b) * 2 + (h)) * HTB)
#define PG8_SB(b, h) ((4 + (b) * 2 + (h)) * HTB)
#define PG8_STAGE(bufoff, gbase, voff) do { _Pragma("unroll") for (int _i = 0; _i < 2; ++_i) \
        __builtin_amdgcn_global_load_lds((const unsigned*)((const char*)(gbase) + (voff)[_i]), (LAS unsigned*)(lds + (bufoff) + ldsw + _i * 8192), 16, 0, 0); } while (0)
#define PG8_LDA(dst, b, h) do { _Pragma("unroll") for (int m = 0; m < 4; ++m) _Pragma("unroll") for (int k = 0; k < 2; ++k) dst[m][k] = *(const LAS bf16x8*)(lds + PG8_SA(b, h) + aoff + m * 2048 + k * 1024); } while (0)
#define PG8_LDB(dst, b, h) do { _Pragma("unroll") for (int n = 0; n < 2; ++n) _Pragma("unroll") for (int k = 0; k < 2; ++k) dst[n][k] = *(const LAS bf16x8*)(lds + PG8_SB(b, h) + boff + n * 2048 + k * 1024); } while (0)
#define PG8_MMA(ai, bj, At, Bt) do { __builtin_amdgcn_s_setprio(1); _Pragma("unroll") for (int m = 0; m < 4; ++m) _Pragma("unroll") for (int n = 0; n < 2; ++n) _Pragma("unroll") for (int k = 0; k < 2; ++k) \
        acc[ai][bj][m][n] = __builtin_amdgcn_mfma_f32_16x16x32_bf16(Bt[n][k], At[m][k], acc[ai][bj][m][n], 0, 0, 0); __builtin_amdgcn_s_setprio(0); } while (0)
#define PG8_WAIT_V(n) asm volatile("s_waitcnt vmcnt(" #n ")" ::: "memory")
#define PG8_WAIT_L(n) asm volatile("s_waitcnt lgkmcnt(" #n ")" ::: "memory")
#define PG8_BAR __builtin_amdgcn_s_barrier()
#define PG8_SCHED __builtin_amdgcn_sched_barrier(0)
    Unit cur, nxt; int ui = 0;
    if (!S.next(0, cur)) return;
    f32x4 acc[2][2][4][2];
#pragma unroll
    for (int a = 0; a < 2; ++a)
#pragma unroll
        for (int b = 0; b < 2; ++b)
#pragma unroll
            for (int m = 0; m < 4; ++m)
#pragma unroll
                for (int n = 0; n < 2; ++n) acc[a][b][m][n] = (f32x4){0.f, 0.f, 0.f, 0.f};
    bf16x8 At[4][2], B0[2][2], B1[2][2];
    const char* cA = (const char*)g.A + (size_t)cur.pm * tstepA; const char* cB = (const char*)g.Bt + (size_t)cur.pn * tstepB;
    PG8_STAGE(PG8_SB(0, 0), cB, voffB); PG8_STAGE(PG8_SA(0, 0), cA, voffA); PG8_STAGE(PG8_SB(0, 1), cB + hstepB, voffB); PG8_STAGE(PG8_SA(0, 1), cA + hstepA, voffA);
    if (wr == 1) PG8_BAR;
    PG8_WAIT_V(4); PG8_BAR;
    PG8_STAGE(PG8_SB(1, 0), cB + kstep, voffB); PG8_STAGE(PG8_SA(1, 0), cA + kstep, voffA); PG8_STAGE(PG8_SB(1, 1), cB + hstepB + kstep, voffB);
    PG8_WAIT_V(6); PG8_BAR;
    for (;;) {
        const bool has_next = S.next(ui + 1, nxt);
        const char* nA = has_next ? (const char*)g.A + (size_t)nxt.pm * tstepA : cA; const char* nB = has_next ? (const char*)g.Bt + (size_t)nxt.pn * tstepB : cB;
        for (int t = 0; t < nt; t += 2) {
            const bool last = (t == nt - 2);
            const char* a1 = cA + (size_t)(t + 1) * kstep;
            const char* a2 = last ? nA : cA + (size_t)(t + 2) * kstep; const char* b2 = last ? nB : cB + (size_t)(t + 2) * kstep;
            const char* a3 = a2 + kstep; const char* b3 = b2 + kstep;
            PG8_LDB(B0, 0, 0); PG8_SCHED; PG8_LDA(At, 0, 0); PG8_STAGE(PG8_SA(1, 1), a1 + hstepA, voffA);
            PG8_WAIT_L(8); PG8_BAR; PG8_WAIT_L(0); PG8_MMA(0, 0, At, B0); PG8_BAR; PG8_SCHED;
            PG8_LDB(B1, 0, 1); PG8_STAGE(PG8_SB(0, 0), b2, voffB);
            PG8_BAR; PG8_WAIT_L(0); PG8_MMA(0, 1, At, B1); PG8_BAR;
            PG8_LDA(At, 0, 1); PG8_STAGE(PG8_SA(0, 0), a2, voffA);
            PG8_BAR; PG8_WAIT_L(0); PG8_MMA(1, 0, At, B0); PG8_BAR; PG8_SCHED;
            PG8_STAGE(PG8_SB(0, 1), b2 + hstepB, voffB);
            PG8_WAIT_V(6); PG8_BAR; PG8_MMA(1, 1, At, B1); PG8_BAR;
            PG8_LDB(B0, 1, 0); PG8_SCHED; PG8_LDA(At, 1, 0); PG8_STAGE(PG8_SA(0, 1), a2 + hstepA, voffA);
            PG8_WAIT_L(8); PG8_BAR; PG8_WAIT_L(0); PG8_MMA(0, 0, At, B0); PG8_BAR; PG8_SCHED;
            PG8_LDB(B1, 1, 1); PG8_STAGE(PG8_SB(1, 0), b3, voffB);
            PG8_BAR; PG8_WAIT_L(0); PG8_MMA(0, 1, At, B1); PG8_BAR;
            PG8_LDA(At, 1, 1); PG8_STAGE(PG8_SA(1, 0), a3, voffA);
            PG8_BAR; PG8_WAIT_L(0); PG8_MMA(1, 0, At, B0); PG8_BAR; PG8_SCHED;
            PG8_STAGE(PG8_SB(1, 1), b3 + hstepB, voffB);
            PG8_WAIT_V(6); PG8_BAR; PG8_MMA(1, 1, At, B1); PG8_BAR;
        }
        E(acc, cur, wr, wc, fr, fq);
        if (!has_next) break;
#pragma unroll
        for (int a = 0; a < 2; ++a)
#pragma unroll
            for (int b = 0; b < 2; ++b)
#pragma unroll
                for (int m = 0; m < 4; ++m)
#pragma unroll
                    for (int n = 0; n < 2; ++n) acc[a][b][m][n] = (f32x4){0.f, 0.f, 0.f, 0.f};
        cur = nxt; cA = nA; cB = nB; ++ui;
    }
    PG8_WAIT_V(0);
    if (wr == 0) PG8_BAR;
    PG8_BAR;
#undef PG8_SA
#undef PG8_SB
#undef PG8_STAGE
#undef PG8_LDA
#undef PG8_LDB
#undef PG8_MMA
#undef PG8_WAIT_V
#undef PG8_WAIT_L
#undef PG8_BAR
#undef PG8_SCHED
}

typedef const f32x4 (&AccRef)[2][2][4][2];

struct EpiF32 {
    static constexpr bool PERM = false;
    float* C; int ldc;
    DEVINL void operator()(AccRef acc, const Unit& u, int wr, int wc, int fr, int fq) const {
        const int row0 = u.pm * BM + wr * 64 + fr, col0 = u.pn * BM + wc * 32 + 4 * fq;
#pragma unroll
        for (int ai = 0; ai < 2; ++ai)
#pragma unroll
            for (int m = 0; m < 4; ++m) { float* rowp = C + (size_t)(row0 + ai * HALF + m * 16) * ldc + col0;
#pragma unroll
                for (int bj = 0; bj < 2; ++bj)
#pragma unroll
                    for (int n = 0; n < 2; ++n) *(f32x4*)(rowp + bj * HALF + n * 16) = acc[ai][bj][m][n]; }
    }
};
template <bool NT> struct EpiBf16T {
    static constexpr bool PERM = true;
    bf16_t* O; int ldc;
    DEVINL void operator()(AccRef acc, const Unit& u, int wr, int wc, int fr, int fq) const {
        const int row0 = u.pm * BM + wr * 64 + fr, col0 = u.pn * BM + wc * 32 + 8 * fq;
#pragma unroll
        for (int ai = 0; ai < 2; ++ai)
#pragma unroll
            for (int m = 0; m < 4; ++m) { bf16_t* rowp = O + (size_t)(row0 + ai * HALF + m * 16) * ldc + col0;
#pragma unroll
                for (int bj = 0; bj < 2; ++bj) { if (NT) store8_nt(rowp + bj * HALF, acc[ai][bj][m][0], acc[ai][bj][m][1]); else store8(rowp + bj * HALF, acc[ai][bj][m][0], acc[ai][bj][m][1]); } }
    }
};
typedef EpiBf16T<false> EpiBf16;
typedef EpiBf16T<true> EpiBf16NT;
struct EpiSwiGLU {
    static constexpr bool PERM = true;
    bf16_t* O;
    DEVINL void operator()(AccRef acc, const Unit& u, int wr, int wc, int fr, int fq) const {
        const int row0 = u.pm * BM + wr * 64 + fr, col0 = u.pn * HALF + wc * 32 + 8 * fq;
#pragma unroll
        for (int ai = 0; ai < 2; ++ai)
#pragma unroll
            for (int m = 0; m < 4; ++m) { bf16_t* rowp = O + (size_t)(row0 + ai * HALF + m * 16) * DFF + col0;
                f32x4 v[2];
#pragma unroll
                for (int n = 0; n < 2; ++n)
#pragma unroll
                    for (int j = 0; j < 4; ++j) { const float gt = acc[ai][0][m][n][j], up = acc[ai][1][m][n][j]; v[n][j] = gt * sigmoidf_(gt) * up; }
                store8_nt(rowp, v[0], v[1]); }
    }
};
struct EpiIn {
    static constexpr bool PERM = true;
    bf16_t* Prwkv; bf16_t* G; bf16_t* Pmla; float* krraw; const float* bgate;
    DEVINL void operator()(AccRef acc, const Unit& u, int wr, int wc, int fr, int fq) const {
        const int row0 = u.pm * BM + wr * 64 + fr, lc0 = wc * 32 + 8 * fq, pn = u.pn;
        if (pn >= 13 && pn < 29) {
            const int cg0 = (pn - 13) * BM + lc0;
            f32x4 bv[2][2];
#pragma unroll
            for (int bj = 0; bj < 2; ++bj)
#pragma unroll
                for (int n = 0; n < 2; ++n) bv[bj][n] = *(const f32x4*)(bgate + cg0 + bj * HALF + 4 * n);
#pragma unroll
            for (int ai = 0; ai < 2; ++ai)
#pragma unroll
                for (int m = 0; m < 4; ++m) { bf16_t* rowp = G + (size_t)(row0 + ai * HALF + m * 16) * 4096 + cg0;
#pragma unroll
                    for (int bj = 0; bj < 2; ++bj) { f32x4 v[2];
#pragma unroll
                        for (int n = 0; n < 2; ++n)
#pragma unroll
                            for (int j = 0; j < 4; ++j) v[n][j] = sigmoidf_(acc[ai][bj][m][n][j] + bv[bj][n][j]);
                        store8(rowp + bj * HALF, v[0], v[1]); } }
        } else if (pn < 32) {
            bf16_t* base = pn < 13 ? Prwkv + pn * BM : Pmla + (pn - 29) * BM; const int ld = pn < 13 ? 3328 : 768;
#pragma unroll
            for (int ai = 0; ai < 2; ++ai)
#pragma unroll
                for (int m = 0; m < 4; ++m) { bf16_t* rowp = base + (size_t)(row0 + ai * HALF + m * 16) * ld + lc0;
#pragma unroll
                    for (int bj = 0; bj < 2; ++bj) store8(rowp + bj * HALF, acc[ai][bj][m][0], acc[ai][bj][m][1]); }
        } else {
            if (wc < 2) {
#pragma unroll
                for (int ai = 0; ai < 2; ++ai)
#pragma unroll
                    for (int m = 0; m < 4; ++m) { float* rowp = krraw + (size_t)(row0 + ai * HALF + m * 16) * 64 + lc0;
                        *(f32x4*)rowp = acc[ai][0][m][0]; *(f32x4*)(rowp + 4) = acc[ai][0][m][1]; }
            }
        }
    }
};
template <int SEL> struct EpiLora {
    static constexpr bool PERM = true;
    bf16_t* O; const float* bias;
    DEVINL void operator()(AccRef acc, const Unit& u, int wr, int wc, int fr, int fq) const {
        const int row0 = u.pm * BM + wr * 64 + fr, c0 = u.pn * BM + wc * 32 + 8 * fq;
#pragma unroll
        for (int bj = 0; bj < 2; ++bj) {
            f32x4 bv[2];
#pragma unroll
            for (int n = 0; n < 2; ++n) bv[n] = (f32x4){0.f, 0.f, 0.f, 0.f};
#pragma unroll
            for (int ai = 0; ai < 2; ++ai)
#pragma unroll
                for (int m = 0; m < 4; ++m) { bf16_t* rowp = O + (size_t)(row0 + ai * HALF + m * 16) * 1024 + c0 + bj * HALF; f32x4 v[2];
#pragma unroll
                    for (int n = 0; n < 2; ++n)
#pragma unroll
                        for (int j = 0; j < 4; ++j) { const float z = acc[ai][bj][m][n][j] + bv[n][j]; v[n][j] = z; }
                    store8(rowp, v[0], v[1]); }
        }
    }
};
template <int MODE> struct EpiGate {
    static constexpr bool PERM = true;
    const bf16_t* G; bf16_t* Mg;
    DEVINL void operator()(AccRef acc, const Unit& u, int wr, int wc, int fr, int fq) const {
        const int row0 = u.pm * BM + wr * 64 + fr, col0 = u.pn * BM + wc * 32 + 8 * fq;
#pragma unroll
        for (int ai = 0; ai < 2; ++ai) {
            u32x4 gq[4][2], mq[4][2];
#pragma unroll
            for (int m = 0; m < 4; ++m)
#pragma unroll
                for (int bj = 0; bj < 2; ++bj) { const size_t r = (size_t)(row0 + ai * HALF + m * 16);
                    gq[m][bj] = __builtin_nontemporal_load((const u32x4*)(G + r * 4096 + col0 + bj * HALF));
                    if (MODE == 1) mq[m][bj] = *(const u32x4*)(Mg + r * 2048 + col0 + bj * HALF); }
#pragma unroll
            for (int m = 0; m < 4; ++m)
#pragma unroll
                for (int bj = 0; bj < 2; ++bj) { const size_t r = (size_t)(row0 + ai * HALF + m * 16);
                    float gf[8], of[8]; unpack8(gq[m][bj], gf); if (MODE == 1) unpack8(mq[m][bj], of);
                    f32x4 v[2];
#pragma unroll
                    for (int n = 0; n < 2; ++n)
#pragma unroll
                        for (int j = 0; j < 4; ++j) { float t = gf[n * 4 + j] * acc[ai][bj][m][n][j]; if (MODE == 1) t += of[n * 4 + j]; v[n][j] = t; }
                    store8(Mg + r * 2048 + col0 + bj * HALF, v[0], v[1]); }
        }
    }
};

template <class Epi>
DEVINL void run_gemm(LAS unsigned char* lds, const bf16_t* A, int lda, const bf16_t* Bt, int ldb, int M, int N, int K, int rot, const Epi& E) {
    asm volatile("" : "+s"(K));
    Gemm g; g.A = A; g.Bt = Bt; g.M = M; g.N = N; g.K = K; g.lda = lda; g.ldb = ldb;
    Order S; S.init(M, N, (int)gridDim.x, (int)((blockIdx.x + rot) % gridDim.x));
    gemm_phase<Epi>(lds, g, S, E);
}

DEVINL void conv_job(LAS unsigned char* lds, const ConvJob& j, int& rot) {
    constexpr int RS = 260;
    const int tid = opaque_tid();
    const int nkb = j.K >> 6, nnb = (j.ncols + 127) >> 7, ntiles = nkb * nnb;
    const int rk = tid >> 3, rc = (tid & 7) * 16;
    const int wn = tid >> 2, wk = (tid & 3) * 16;
    f32x4 v[4];
    auto gload = [&](int tile) {
        const int kb = tile / nnb, nb = tile - kb * nnb, col = nb * 128 + rc;
        if (col < j.ncols) { const int grp = col / j.gs, r = col - grp * j.gs;
            const float* sp = j.src + (size_t)(kb * 64 + rk) * j.ldn + j.c0 + grp * j.sstride + r;
#pragma unroll
            for (int i = 0; i < 4; ++i) v[i] = __builtin_nontemporal_load((const f32x4*)(sp + 4 * i)); }
        else {
#pragma unroll
            for (int i = 0; i < 4; ++i) v[i] = (f32x4){0.f, 0.f, 0.f, 0.f}; }
    };
    const int G_ = (int)gridDim.x; int tile = ((int)blockIdx.x + G_ - rot % G_) % G_; rot += ntiles;
    if (tile < ntiles) gload(tile);
    for (; tile < ntiles; tile += gridDim.x) {
        unsigned pk[8];
#pragma unroll
        for (int i = 0; i < 4; ++i) { pk[2 * i] = cvt_pk_bf16(v[i][0], v[i][1]); pk[2 * i + 1] = cvt_pk_bf16(v[i][2], v[i][3]); }
        LAS unsigned* wp = (LAS unsigned*)(lds + rk * RS + rc * 2);
#pragma unroll
        for (int i = 0; i < 8; ++i) wp[i] = pk[i];
        const int nxt = tile + (int)gridDim.x;
        if (nxt < ntiles) gload(nxt);
        __syncthreads();
        const int kb = tile / nnb, nb = tile - kb * nnb, col = nb * 128 + wn;
        unsigned short e[16];
#pragma unroll
        for (int i = 0; i < 16; ++i) e[i] = *(const LAS unsigned short*)(lds + (wk + i) * RS + wn * 2);
        if (col < j.ncols) { const int grp = col / j.gs, r = col - grp * j.gs;
            bf16_t* d = j.dst + (size_t)(grp * j.dstride + r) * j.ldk + kb * 64 + wk;
            u32x4 w0, w1;
            w0.x = e[0] | ((unsigned)e[1] << 16); w0.y = e[2] | ((unsigned)e[3] << 16); w0.z = e[4] | ((unsigned)e[5] << 16); w0.w = e[6] | ((unsigned)e[7] << 16);
            w1.x = e[8] | ((unsigned)e[9] << 16); w1.y = e[10] | ((unsigned)e[11] << 16); w1.z = e[12] | ((unsigned)e[13] << 16); w1.w = e[14] | ((unsigned)e[15] << 16);
            *(u32x4*)d = w0; *(u32x4*)(d + 8) = w1; }
        __syncthreads();
    }
}
template <int J, int E> DEVINL void conv_range(LAS unsigned char* lds, const Params& p, int& rot) {
    if constexpr (J < E) { conv_job(lds, p.jobs[J], rot); conv_range<J + 1, E>(lds, p, rot); }
}
DEVINL void zero_lora(bf16_t* W) {
    for (int idx = blockIdx.x * 512 + opaque_tid(); idx < 3072 * 32; idx += gridDim.x * 512) {
        const int row = idx >> 5, k8 = (idx & 31) * 8, sel = row >> 10;
        const bool data = sel == 0 ? (k8 < 64) : (sel == 1 ? (k8 >= 64 && k8 < 128) : (k8 >= 128));
        if (!data) *(u32x4*)(W + (size_t)row * 256 + k8) = (u32x4){0u, 0u, 0u, 0u};
    }
}

DEVINL void rmsnorm_rows(const float* x, const float* g, bf16_t* out, int rows) {
    const int tid_ = opaque_tid(), lane = tid_ & 63, gw = blockIdx.x * 8 + (tid_ >> 6), nw = gridDim.x * 8;
    for (int t = gw; t < rows; t += 2 * nw) {
        const bool two = (t + nw) < rows; const int tb = two ? t + nw : t;
        f32x4 va[8], vb[8]; float sa = 0.f, sb = 0.f;
#pragma unroll
        for (int j = 0; j < 8; ++j) { va[j] = __builtin_nontemporal_load((const f32x4*)(x + (size_t)t * D + (j * 64 + lane) * 4)); vb[j] = __builtin_nontemporal_load((const f32x4*)(x + (size_t)tb * D + (j * 64 + lane) * 4));
            sa += va[j][0] * va[j][0] + va[j][1] * va[j][1] + va[j][2] * va[j][2] + va[j][3] * va[j][3];
            sb += vb[j][0] * vb[j][0] + vb[j][1] * vb[j][1] + vb[j][2] * vb[j][2] + vb[j][3] * vb[j][3]; }
#pragma unroll
        for (int o = 32; o >= 1; o >>= 1) { sa += __shfl_xor(sa, o); sb += __shfl_xor(sb, o); }
        const float ra = rsqrtf(sa * (1.0f / D) + 1e-6f), rb = rsqrtf(sb * (1.0f / D) + 1e-6f);
#pragma unroll
        for (int j = 0; j < 8; ++j) { const f32x4 gg = *(const f32x4*)(g + (j * 64 + lane) * 4); u32x2 wa, wb;
            wa.x = cvt_pk_bf16(va[j][0] * ra * gg[0], va[j][1] * ra * gg[1]); wa.y = cvt_pk_bf16(va[j][2] * ra * gg[2], va[j][3] * ra * gg[3]);
            wb.x = cvt_pk_bf16(vb[j][0] * rb * gg[0], vb[j][1] * rb * gg[1]); wb.y = cvt_pk_bf16(vb[j][2] * rb * gg[2], vb[j][3] * rb * gg[3]);
            *(u32x2*)(out + (size_t)t * D + (j * 64 + lane) * 4) = wa;
            if (two) *(u32x2*)(out + (size_t)tb * D + (j * 64 + lane) * 4) = wb; }
    }
}
DEVINL void row_update(const bf16_t* y, const float* xin, float* xout, const float* gpost, float coef, const float* gpre, bf16_t* h) {
    const int tid_ = opaque_tid(), lane = tid_ & 63, gw = blockIdx.x * 8 + (tid_ >> 6), nw = gridDim.x * 8;
    for (int t = gw; t < T; t += 2 * nw) {
        const bool two = (t + nw) < T; const int tb = two ? t + nw : t;
        f32x4 va[8], vb[8], xa_[8], xb_[8]; float sa = 0.f, sb = 0.f;
#pragma unroll
        for (int j = 0; j < 8; ++j) {
            xa_[j] = __builtin_nontemporal_load((const f32x4*)(xin + (size_t)t * D + (j * 64 + lane) * 4)); xb_[j] = __builtin_nontemporal_load((const f32x4*)(xin + (size_t)tb * D + (j * 64 + lane) * 4)); }
#pragma unroll
        for (int j = 0; j < 8; ++j) {
            const u32x2 ya = __builtin_nontemporal_load((const u32x2*)(y + (size_t)t * D + (j * 64 + lane) * 4)), yb = __builtin_nontemporal_load((const u32x2*)(y + (size_t)tb * D + (j * 64 + lane) * 4));
            va[j] = (f32x4){bflo(ya.x), bfhi(ya.x), bflo(ya.y), bfhi(ya.y)}; vb[j] = (f32x4){bflo(yb.x), bfhi(yb.x), bflo(yb.y), bfhi(yb.y)};
            sa += va[j][0] * va[j][0] + va[j][1] * va[j][1] + va[j][2] * va[j][2] + va[j][3] * va[j][3];
            sb += vb[j][0] * vb[j][0] + vb[j][1] * vb[j][1] + vb[j][2] * vb[j][2] + vb[j][3] * vb[j][3]; }
#pragma unroll
        for (int o = 32; o >= 1; o >>= 1) { sa += __shfl_xor(sa, o); sb += __shfl_xor(sb, o); }
        const float ra = rsqrtf(sa * (1.0f / D) + 1e-6f) * coef, rb = rsqrtf(sb * (1.0f / D) + 1e-6f) * coef; float qa = 0.f, qb = 0.f;
#pragma unroll
        for (int j = 0; j < 8; ++j) { const f32x4 gg = *(const f32x4*)(gpost + (j * 64 + lane) * 4);
            const f32x4 xa = xa_[j], xb = xb_[j];
            va[j] = xa + va[j] * ra * gg; vb[j] = xb + vb[j] * rb * gg;
            qa += va[j][0] * va[j][0] + va[j][1] * va[j][1] + va[j][2] * va[j][2] + va[j][3] * va[j][3];
            qb += vb[j][0] * vb[j][0] + vb[j][1] * vb[j][1] + vb[j][2] * vb[j][2] + vb[j][3] * vb[j][3];
            __builtin_nontemporal_store(va[j], (f32x4*)(xout + (size_t)t * D + (j * 64 + lane) * 4));
            if (two) __builtin_nontemporal_store(vb[j], (f32x4*)(xout + (size_t)tb * D + (j * 64 + lane) * 4)); }
        if (h) {
#pragma unroll
            for (int o = 32; o >= 1; o >>= 1) { qa += __shfl_xor(qa, o); qb += __shfl_xor(qb, o); }
            const float r2a = rsqrtf(qa * (1.0f / D) + 1e-6f), r2b = rsqrtf(qb * (1.0f / D) + 1e-6f);
#pragma unroll
            for (int j = 0; j < 8; ++j) { const f32x4 gg = *(const f32x4*)(gpre + (j * 64 + lane) * 4); u32x2 wa, wb;
                wa.x = cvt_pk_bf16(va[j][0] * r2a * gg[0], va[j][1] * r2a * gg[1]); wa.y = cvt_pk_bf16(va[j][2] * r2a * gg[2], va[j][3] * r2a * gg[3]);
                wb.x = cvt_pk_bf16(vb[j][0] * r2b * gg[0], vb[j][1] * r2b * gg[1]); wb.y = cvt_pk_bf16(vb[j][2] * r2b * gg[2], vb[j][3] * r2b * gg[3]);
                *(u32x2*)(h + (size_t)t * D + (j * 64 + lane) * 4) = wa;
                if (two) *(u32x2*)(h + (size_t)tb * D + (j * 64 + lane) * 4) = wb; }
        }
    }
}
__device__ const double c_inv_freq[32] = {
    1.0, 0.7498942093324559, 0.5623413251903491, 0.4216965034285822, 0.31622776601683794, 0.23713737056616552, 0.1778279410038923, 0.1333521432163324,
    0.1, 0.07498942093324558, 0.05623413251903491, 0.04216965034285822, 0.03162277660168379, 0.023713737056616554, 0.01778279410038923, 0.01333521432163324,
    0.01, 0.007498942093324558, 0.005623413251903491, 0.004216965034285823, 0.0031622776601683794, 0.0023713737056616554, 0.0017782794100389228, 0.001333521432163324,
    0.001, 0.0007498942093324559, 0.0005623413251903491, 0.0004216965034285823, 0.00031622776601683794, 0.00023713737056616554, 0.00017782794100389227, 0.0001333521432163324};
DEVINL void cs_table(const int* pos, f32x2* cs) {
    for (int idx = blockIdx.x * 512 + opaque_tid(); idx < T * 32; idx += gridDim.x * 512) {
        const int t = idx >> 5, i = idx & 31;
        const double rev = (double)pos[t] * c_inv_freq[i] * 0.15915494309189535;
        const float fr = (float)(rev - floor(rev)) * 6.2831853071795865f;
        cs[idx] = (f32x2){__cosf(fr), __sinf(fr)};
    }
}
DEVINL void mix_prep(bf16_t* Pmla, const float* nq, const float* nkv, const float* krraw, const f32x2* cs, bf16_t* kr,
                     const bf16_t* Prwkv, const float* mu, bf16_t* lin) {
    const int tid_ = opaque_tid(), lane = tid_ & 63, gw = blockIdx.x * 8 + (tid_ >> 6), nw = gridDim.x * 8;
    const int col = 3072 + lane * 4;
    for (int t = gw; t < T; t += nw) {
        bf16_t* pr = Pmla + (size_t)t * 768;
        const u32x4 wq = *(const u32x4*)(pr + lane * 8); const u32x2 wkv = *(const u32x2*)(pr + 512 + lane * 4);
        const int l32 = lane & 31;
        const float x1 = krraw[(size_t)t * 64 + l32], x2 = krraw[(size_t)t * 64 + 32 + l32]; const f32x2 c = cs[(size_t)t * 32 + l32];
        const u32x2 cw = *(const u32x2*)(Prwkv + (size_t)t * 3328 + col);
        u32x2 pw = (u32x2){0u, 0u}; if ((t & (SEQ - 1)) != 0) pw = *(const u32x2*)(Prwkv + (size_t)(t - 1) * 3328 + col);
        float f[8]; unpack8(wq, f); float ssq = 0.f;
#pragma unroll
        for (int i = 0; i < 8; ++i) ssq += f[i] * f[i];
        const float f0 = bflo(wkv.x), f1 = bfhi(wkv.x), f2 = bflo(wkv.y), f3 = bfhi(wkv.y); float ssk = f0 * f0 + f1 * f1 + f2 * f2 + f3 * f3;
#pragma unroll
        for (int o = 32; o >= 1; o >>= 1) { ssq += __shfl_xor(ssq, o); ssk += __shfl_xor(ssk, o); }
        { const float rs = rsqrtf(ssq * (1.0f / 512) + 1e-6f);
            const f32x4 g0 = *(const f32x4*)(nq + lane * 8), g1 = *(const f32x4*)(nq + lane * 8 + 4);
            store8(pr + lane * 8, (f32x4){f[0] * rs * g0[0], f[1] * rs * g0[1], f[2] * rs * g0[2], f[3] * rs * g0[3]}, (f32x4){f[4] * rs * g1[0], f[5] * rs * g1[1], f[6] * rs * g1[2], f[7] * rs * g1[3]}); }
        { const float rs = rsqrtf(ssk * (1.0f / 256) + 1e-6f);
            const f32x4 g0 = *(const f32x4*)(nkv + lane * 4); u32x2 o; o.x = cvt_pk_bf16(f0 * rs * g0[0], f1 * rs * g0[1]); o.y = cvt_pk_bf16(f2 * rs * g0[2], f3 * rs * g0[3]);
            *(u32x2*)(pr + 512 + lane * 4) = o; }
        if (lane < 32) {
            const unsigned lo = cvt_pk_bf16(x1 * c.x - x2 * c.y, 0.f), hi = cvt_pk_bf16(x1 * c.y + x2 * c.x, 0.f);
            kr[(size_t)t * 64 + lane] = (bf16_t)(lo & 0xffffu); kr[(size_t)t * 64 + 32 + lane] = (bf16_t)(hi & 0xffffu); }
        { const f32x4 m4 = *(const f32x4*)(mu + col);
            float c4[4] = {bflo(cw.x), bfhi(cw.x), bflo(cw.y), bfhi(cw.y)}; const float p4[4] = {bflo(pw.x), bfhi(pw.x), bflo(pw.y), bfhi(pw.y)};
#pragma unroll
            for (int i = 0; i < 4; ++i) { float p = c4[i] + (p4[i] - c4[i]) * m4[i];
                if (lane < 16) p = 1.0f - 2.0f * __builtin_amdgcn_rcpf(__expf(2.0f * p) + 1.0f); else if (lane >= 32) p = sigmoidf_(p);
                c4[i] = p; }
            u32x2 o; o.x = cvt_pk_bf16(c4[0], c4[1]); o.y = cvt_pk_bf16(c4[2], c4[3]); *(u32x2*)(lin + (size_t)t * 256 + lane * 4) = o; }
    }
}

template <int DQK, int D1, int DV, bool MLA, int NQ>
DEVINL void attn_block(LAS unsigned char* lds, const bf16_t* q, int ldq, const bf16_t* k1, int ld1, const bf16_t* k2, int ld2,
                       const bf16_t* vt, int ldv, bf16_t* o, int ldo, int nt, int qtile0, const f32x2* cs, float sc) {
    constexpr int KS = DQK * 2 + 16, VS = 144, BUF = 64 * KS + DV * VS, NKS = DQK / 32, NDB = DV / 16;
    constexpr int NC1 = D1 / 64, D2 = DQK - D1, NCV = DV / 64, CPR1 = D1 / 8;
    const int tid = opaque_tid(), wid = tid >> 6, lane = tid & 63, fr = lane & 15, fq = lane >> 4;
    const int jmax = MLA ? qtile0 + ((wid * 16 * NQ) >> 6) : nt - 1;
    bf16x8 qf[NQ][NKS];
#pragma unroll
    for (int qi = 0; qi < NQ; ++qi) { const int row = wid * 16 * NQ + qi * 16 + fr; const bf16_t* qrow = q + (size_t)row * ldq + fq * 8;
#pragma unroll
        for (int ks = 0; ks < NKS; ++ks) qf[qi][ks] = *(const bf16x8*)(qrow + ks * 32);
        if (MLA) {
            const f32x2* c = cs + (size_t)row * 32 + fq * 8;
            float x1[8], x2[8]; unpack8(__builtin_bit_cast(u32x4, qf[qi][4]), x1); unpack8(__builtin_bit_cast(u32x4, qf[qi][5]), x2);
            float n1[8], n2[8];
#pragma unroll
            for (int i = 0; i < 8; ++i) { const f32x2 ci = c[i]; n1[i] = x1[i] * ci.x - x2[i] * ci.y; n2[i] = x1[i] * ci.y + x2[i] * ci.x; }
            u32x4 w1, w2; w1.x = cvt_pk_bf16(n1[0], n1[1]); w1.y = cvt_pk_bf16(n1[2], n1[3]); w1.z = cvt_pk_bf16(n1[4], n1[5]); w1.w = cvt_pk_bf16(n1[6], n1[7]);
            w2.x = cvt_pk_bf16(n2[0], n2[1]); w2.y = cvt_pk_bf16(n2[2], n2[3]); w2.z = cvt_pk_bf16(n2[4], n2[5]); w2.w = cvt_pk_bf16(n2[6], n2[7]);
            qf[qi][4] = __builtin_bit_cast(bf16x8, w1); qf[qi][5] = __builtin_bit_cast(bf16x8, w2);
        } }
    f32x4 acc[NQ][NDB];
#pragma unroll
    for (int qi = 0; qi < NQ; ++qi)
#pragma unroll
        for (int i = 0; i < NDB; ++i) acc[qi][i] = (f32x4){0.f, 0.f, 0.f, 0.f};
    float mrun[NQ], lrun[NQ];
#pragma unroll
    for (int qi = 0; qi < NQ; ++qi) { mrun[qi] = -INFINITY; lrun[qi] = 0.f; }
    u32x4 r1[NC1], r2, rv[NCV];
    auto gload = [&](int key0) {
#pragma unroll
        for (int i = 0; i < NC1; ++i) { const int c = tid + i * 512, row = c / CPR1, cc = c % CPR1; r1[i] = *(const u32x4*)(k1 + (size_t)(key0 + row) * ld1 + cc * 8); }
        if (D2 > 0) { const int row = tid >> 3, cc = tid & 7; r2 = *(const u32x4*)(k2 + (size_t)(key0 + row) * ld2 + cc * 8); }
#pragma unroll
        for (int i = 0; i < NCV; ++i) { const int c = tid + i * 512, row = c >> 3, cc = c & 7; rv[i] = *(const u32x4*)(vt + (size_t)row * ldv + key0 + cc * 8); }
    };
    auto lstore = [&](LAS unsigned char* b) {
#pragma unroll
        for (int i = 0; i < NC1; ++i) { const int c = tid + i * 512, row = c / CPR1, cc = c % CPR1; *(LAS u32x4*)(b + row * KS + cc * 16) = r1[i]; }
        if (D2 > 0) { const int row = tid >> 3, cc = tid & 7; *(LAS u32x4*)(b + row * KS + D1 * 2 + cc * 16) = r2; }
#pragma unroll
        for (int i = 0; i < NCV; ++i) { const int c = tid + i * 512, row = c >> 3, cc = c & 7; *(LAS u32x4*)(b + 64 * KS + row * VS + cc * 16) = rv[i]; }
    };
    gload(0); lstore(lds); __syncthreads();
    for (int j = 0; j < nt; ++j) {
        LAS unsigned char* cb = lds + (j & 1) * BUF;
        if (j + 1 < nt) gload((j + 1) * 64);
        if (j <= jmax) {
            f32x4 s[NQ][4];
#pragma unroll
            for (int kb = 0; kb < 4; ++kb) {
#pragma unroll
                for (int qi = 0; qi < NQ; ++qi) s[qi][kb] = (f32x4){0.f, 0.f, 0.f, 0.f};
#pragma unroll
                for (int ks = 0; ks < NKS; ++ks) { const bf16x8 a = *(const LAS bf16x8*)(cb + (kb * 16 + fr) * KS + ks * 64 + fq * 16);
#pragma unroll
                    for (int qi = 0; qi < NQ; ++qi) s[qi][kb] = __builtin_amdgcn_mfma_f32_16x16x32_bf16(a, qf[qi][ks], s[qi][kb], 0, 0, 0); } }
            bf16x8 pf[NQ][2];
#pragma unroll
            for (int qi = 0; qi < NQ; ++qi) {
                float mx = s[qi][0][0];
#pragma unroll
                for (int kb = 0; kb < 4; ++kb)
#pragma unroll
                    for (int i = 0; i < 4; ++i) mx = fmaxf(mx, s[qi][kb][i]);
                mx = fmaxf(mx, __shfl_xor(mx, 16)); mx = fmaxf(mx, __shfl_xor(mx, 32));
                const float mnew = fmaxf(mrun[qi], mx * sc), alpha = __builtin_amdgcn_exp2f(mrun[qi] - mnew);
                mrun[qi] = mnew; float ls = 0.f;
#pragma unroll
                for (int kb = 0; kb < 4; ++kb)
#pragma unroll
                    for (int i = 0; i < 4; ++i) { const float p = __builtin_amdgcn_exp2f(s[qi][kb][i] * sc - mnew); s[qi][kb][i] = p; ls += p; }
                lrun[qi] = lrun[qi] * alpha + ls;
#pragma unroll
                for (int i = 0; i < NDB; ++i) acc[qi][i] *= alpha;
#pragma unroll
                for (int ks = 0; ks < 2; ++ks) { u32x4 pw; pw.x = cvt_pk_bf16(s[qi][2 * ks][0], s[qi][2 * ks][1]); pw.y = cvt_pk_bf16(s[qi][2 * ks][2], s[qi][2 * ks][3]); pw.z = cvt_pk_bf16(s[qi][2 * ks + 1][0], s[qi][2 * ks + 1][1]); pw.w = cvt_pk_bf16(s[qi][2 * ks + 1][2], s[qi][2 * ks + 1][3]);
                    pf[qi][ks] = __builtin_bit_cast(bf16x8, pw); }
            }
#pragma unroll
            for (int ks = 0; ks < 2; ++ks)
#pragma unroll
                for (int db = 0; db < NDB; ++db) { const LAS unsigned char* vp = cb + 64 * KS + (db * 16 + fr) * VS + (32 * ks + 4 * fq) * 2;
                    const u32x2 lo = *(const LAS u32x2*)vp, hi = *(const LAS u32x2*)(vp + 32);
                    const bf16x8 a = __builtin_bit_cast(bf16x8, (u32x4){lo.x, lo.y, hi.x, hi.y});
#pragma unroll
                    for (int qi = 0; qi < NQ; ++qi) acc[qi][db] = __builtin_amdgcn_mfma_f32_16x16x32_bf16(a, pf[qi][ks], acc[qi][db], 0, 0, 0); }
        }
        if (j + 1 < nt) lstore(lds + ((j + 1) & 1) * BUF);
        __syncthreads();
    }
#pragma unroll
    for (int qi = 0; qi < NQ; ++qi) {
        float l = lrun[qi]; l += __shfl_xor(l, 16); l += __shfl_xor(l, 32);
        const float inv = 1.0f / l;
        bf16_t* orow = o + (size_t)(wid * 16 * NQ + qi * 16 + fr) * ldo + 4 * fq;
#pragma unroll
        for (int db = 0; db < NDB; ++db) { u32x2 w; w.x = cvt_pk_bf16(acc[qi][db][0] * inv, acc[qi][db][1] * inv); w.y = cvt_pk_bf16(acc[qi][db][2] * inv, acc[qi][db][3] * inv); *(u32x2*)(orow + db * 16) = w; }
    }
}

DEVINL void mla_attention(LAS unsigned char* lds, const bf16_t* q, const bf16_t* kn, const bf16_t* kr, const bf16_t* vt, bf16_t* o, const f32x2* cs) {
    const int c = blockIdx.x, x = c & 7, r = c >> 3;
    const float sc = 0.07216878364870322f * 1.4426950408889634f;
    for (int i = 0; (i * (int)gridDim.x + c) < 512 && i < 64; ++i) {
        int bh, pair;
        if (gridDim.x == 256) { bh = i * 64 + x * 8 + (r >> 2); pair = r & 3; } else { const int uu = i * gridDim.x + c; bh = uu >> 2; pair = uu & 3; }
        const int b = bh >> 3, h = bh & 7;
#pragma unroll 1
        for (int half = 0; half < 2; ++half) {
            const int qb = half == 0 ? pair : 7 - pair, q0 = qb * 256; const size_t t0 = (size_t)b * SEQ;
            attn_block<192, 128, 128, true, 2>(lds, q + (t0 + q0) * 1536 + h * 192, 1536, kn + t0 * 1024 + h * 128, 1024, kr + t0 * 64, 64,
                                               vt + (size_t)(h * 128) * T + t0, T, o + (t0 + q0) * 1024 + h * 128, 1024, 4 * qb + 4, 4 * qb, cs + (t0 + q0) * 32, sc);
        }
    }
}
DEVINL void mem_attention(LAS unsigned char* lds, const bf16_t* qx, const bf16_t* km, const bf16_t* vtm, bf16_t* o) {
    const int c = blockIdx.x, x = c & 7, r = c >> 3;
    const float sc = 0.0625f * 1.4426950408889634f;
    for (int i = 0; (i * (int)gridDim.x + c) < 1024 && i < 64; ++i) {
        int bh, qb;
        if (gridDim.x == 256) { bh = i * 16 + x * 2 + (r >> 4); qb = r & 15; } else { const int uu = i * gridDim.x + c; bh = uu >> 4; qb = uu & 15; }
        const int b = bh >> 2, h = bh & 3; const size_t t0 = (size_t)b * SEQ + qb * 128;
        attn_block<256, 256, 256, false, 1>(lds, qx + t0 * 1024 + h * 256, 1024, km + (size_t)(b * 256) * 1024 + h * 256, 1024, nullptr, 0,
                                            vtm + (size_t)(h * 256) * NMEMT + b * 256, NMEMT, o + t0 * 1024 + h * 256, 1024, 4, 0, nullptr, sc);
    }
}

constexpr int CH = 32;
DEVINL void rwkv_scan(LAS unsigned char* lds, const bf16_t* Prwkv, const bf16_t* Aa, const bf16_t* Gg, const bf16_t* Uu, const float* w0v, const float* a0v, const float* mu,
                      const float* k_k, const float* k_a, const float* r_k, const float* lnx_w, const float* lnx_b, bf16_t* out) {
    LAS float* IN = (LAS float*)lds;
    LAS float* OUT = (LAS float*)(lds + 2 * 6 * CH * 64 * 4);
    LAS float* SC = (LAS float*)(lds + 2 * 6 * CH * 64 * 4 + 2 * CH * 64 * 4);
    const int tid = opaque_tid(), wid = tid >> 6, lane = tid & 63;
    for (int bh = blockIdx.x; bh < NB * 16; bh += gridDim.x) {
        const int b = bh >> 4, h = bh & 15; const size_t t0 = (size_t)b * SEQ;
        const int ht = tid - 256, hstep = ht >> 3, hc = (ht & 7) * 8;
        u32x4 qcr, qck, qcv, qpr, qpk, qpv, qa, qu, gq;
        auto load_raw = [&](int cc) {
            const int s = cc * CH + hstep; const size_t t = t0 + s; const int cb = h * 64 + hc;
            const bf16_t* pc = Prwkv + t * 3328 + cb;
            qcr = *(const u32x4*)(pc); qck = *(const u32x4*)(pc + 1024); qcv = *(const u32x4*)(pc + 2048);
            qpr = (u32x4){0u, 0u, 0u, 0u}; qpk = qpr; qpv = qpr;
            if (s > 0) { qpr = *(const u32x4*)(pc - 3328); qpk = *(const u32x4*)(pc - 3328 + 1024); qpv = *(const u32x4*)(pc - 3328 + 2048); }
            qa = __builtin_nontemporal_load((const u32x4*)(Aa + t * 1024 + cb)); qu = __builtin_nontemporal_load((const u32x4*)(Uu + t * 1024 + cb));
        };
        auto load_gate = [&](int cc) { gq = __builtin_nontemporal_load((const u32x4*)(Gg + (t0 + cc * CH + hstep) * 1024 + h * 64 + hc)); };
        auto prep = [&](int cc) {
            const int cb = h * 64 + hc;
            LAS float* base = IN + (cc & 1) * (6 * CH * 64) + hstep * 64 + hc;
            float rr[8], tmp[8], prv[8], av[8], kk[8];
            unpack8(qcr, rr); unpack8(qpr, prv);
#pragma unroll
            for (int i = 0; i < 8; ++i) rr[i] += (prv[i] - rr[i]) * mu[cb + i];
            unpack8(qcv, tmp); unpack8(qpv, prv);
#pragma unroll
            for (int i = 0; i < 8; ++i) tmp[i] += (prv[i] - tmp[i]) * mu[2048 + cb + i];
            *(LAS f32x4*)(base + 3 * CH * 64) = (f32x4){tmp[0], tmp[1], tmp[2], tmp[3]}; *(LAS f32x4*)(base + 3 * CH * 64 + 4) = (f32x4){tmp[4], tmp[5], tmp[6], tmp[7]};
            asm volatile("" ::: "memory");
            unpack8(qu, tmp);
#pragma unroll
            for (int i = 0; i < 8; ++i) { tmp[i] = __expf(-0.60653066f * sigmoidf_(tmp[i] + w0v[cb + i])); prv[i] = tmp[i] * rr[i]; }
            *(LAS f32x4*)(base + 1 * CH * 64) = (f32x4){tmp[0], tmp[1], tmp[2], tmp[3]}; *(LAS f32x4*)(base + 1 * CH * 64 + 4) = (f32x4){tmp[4], tmp[5], tmp[6], tmp[7]};
            *(LAS f32x4*)(base + 0 * CH * 64) = (f32x4){prv[0], prv[1], prv[2], prv[3]}; *(LAS f32x4*)(base + 0 * CH * 64 + 4) = (f32x4){prv[4], prv[5], prv[6], prv[7]};
            asm volatile("" ::: "memory");
            unpack8(qa, av);
#pragma unroll
            for (int i = 0; i < 8; ++i) av[i] = sigmoidf_(av[i] + a0v[cb + i]);
            unpack8(qck, tmp); unpack8(qpk, prv); float ss = 0.f, pkr = 0.f, pbs = 0.f, pbr = 0.f;
#pragma unroll
            for (int i = 0; i < 8; ++i) { const float kx = tmp[i] + (prv[i] - tmp[i]) * mu[1024 + cb + i]; kk[i] = kx * k_k[cb + i]; ss += kk[i] * kk[i]; tmp[i] = kx * (1.0f + (av[i] - 1.0f) * k_a[cb + i]);
                const float rk = rr[i] * tmp[i]; pkr += rk; pbs += rk * r_k[cb + i]; }
            *(LAS f32x4*)(base + 2 * CH * 64) = (f32x4){tmp[0], tmp[1], tmp[2], tmp[3]}; *(LAS f32x4*)(base + 2 * CH * 64 + 4) = (f32x4){tmp[4], tmp[5], tmp[6], tmp[7]};
            ss = sum8(ss); const float rn = 1.0f / fmaxf(sqrtf(ss), 1e-12f);
#pragma unroll
            for (int i = 0; i < 8; ++i) kk[i] *= rn;
            *(LAS f32x4*)(base + 4 * CH * 64) = (f32x4){kk[0], kk[1], kk[2], kk[3]}; *(LAS f32x4*)(base + 4 * CH * 64 + 4) = (f32x4){kk[4], kk[5], kk[6], kk[7]};
#pragma unroll
            for (int i = 0; i < 8; ++i) { kk[i] *= av[i]; pbr += kk[i] * rr[i]; }
            *(LAS f32x4*)(base + 5 * CH * 64) = (f32x4){kk[0], kk[1], kk[2], kk[3]}; *(LAS f32x4*)(base + 5 * CH * 64 + 4) = (f32x4){kk[4], kk[5], kk[6], kk[7]};
            pbr = sum8(pbr); pkr = sum8(pkr); pbs = sum8(pbs);
            if ((ht & 7) == 0) { LAS float* sc = SC + (cc & 1) * (3 * CH) + hstep; sc[0] = pbr; sc[CH] = pkr; sc[2 * CH] = pbs; }
        };
        auto post = [&](int cc) {
            const int s = cc * CH + hstep; const size_t t = t0 + s;
            const LAS float* ib = IN + (cc & 1) * (6 * CH * 64) + hstep * 64 + hc; const LAS float* ob = OUT + (cc & 1) * (CH * 64) + hstep * 64 + hc;
            float ov[8], vv[8], gv[8];
            { const f32x4 a0 = *(const LAS f32x4*)ob, a1 = *(const LAS f32x4*)(ob + 4); ov[0] = a0[0]; ov[1] = a0[1]; ov[2] = a0[2]; ov[3] = a0[3]; ov[4] = a1[0]; ov[5] = a1[1]; ov[6] = a1[2]; ov[7] = a1[3]; }
            { const f32x4 a0 = *(const LAS f32x4*)(ib + 3 * CH * 64), a1 = *(const LAS f32x4*)(ib + 3 * CH * 64 + 4); vv[0] = a0[0]; vv[1] = a0[1]; vv[2] = a0[2]; vv[3] = a0[3]; vv[4] = a1[0]; vv[5] = a1[1]; vv[6] = a1[2]; vv[7] = a1[3]; }
            const float bs = SC[(cc & 1) * (3 * CH) + 2 * CH + hstep];
            unpack8(gq, gv);
            float sm = 0.f;
#pragma unroll
            for (int i = 0; i < 8; ++i) sm += ov[i];
            sm = sum8(sm); const float mean = sm * (1.0f / 64); float vs = 0.f;
#pragma unroll
            for (int i = 0; i < 8; ++i) { const float d = ov[i] - mean; vs += d * d; }
            vs = sum8(vs); const float rs = rsqrtf(vs * (1.0f / 64) + 64e-5f);
            float res[8];
#pragma unroll
            for (int i = 0; i < 8; ++i) { const int cidx = h * 64 + hc + i; res[i] = ((ov[i] - mean) * rs * lnx_w[cidx] + lnx_b[cidx] + bs * vv[i]) * gv[i]; }
            store8(out + t * 1024 + h * 64 + hc, (f32x4){res[0], res[1], res[2], res[3]}, (f32x4){res[4], res[5], res[6], res[7]});
        };
        const int kp = (lane & 7) * 8, v0 = wid * 8 + (lane >> 3), v1 = v0 + 32;
        f32x2 st0[4], st1[4];
#pragma unroll
        for (int i = 0; i < 4; ++i) { st0[i] = (f32x2){0.f, 0.f}; st1[i] = (f32x2){0.f, 0.f}; }
        if (wid < 4) {
          __syncthreads();
          for (int cc = 0; cc < SEQ / CH; ++cc) {
            {
                const LAS float* ib = IN + (cc & 1) * (6 * CH * 64); LAS float* ob = OUT + (cc & 1) * (CH * 64); const LAS float* sc_ = SC + (cc & 1) * (3 * CH);
                f32x4 Ka[2], Kb[2]; float Av0, Av1, Bv0, Bv1;
#define SCAN_LDK(X, X0, X1, s_) do { const LAS float* p_ = ib + (s_) * 64 + kp; \
                    X[0] = *(const LAS f32x4*)(p_ + 4 * CH * 64); X[1] = *(const LAS f32x4*)(p_ + 4 * CH * 64 + 4); \
                    X0 = ib[3 * CH * 64 + (s_) * 64 + v0]; X1 = ib[3 * CH * 64 + (s_) * 64 + v1]; } while (0)
#define SCAN_STEP(X, X0, X1, s_, PRE) do { const LAS float* p_ = ib + (s_) * 64 + kp; f32x4 Y[8]; \
                    Y[0] = *(const LAS f32x4*)(p_ + 0 * CH * 64); Y[1] = *(const LAS f32x4*)(p_ + 0 * CH * 64 + 4); \
                    Y[2] = *(const LAS f32x4*)(p_ + 1 * CH * 64); Y[3] = *(const LAS f32x4*)(p_ + 1 * CH * 64 + 4); \
                    Y[4] = *(const LAS f32x4*)(p_ + 5 * CH * 64); Y[5] = *(const LAS f32x4*)(p_ + 5 * CH * 64 + 4); \
                    Y[6] = *(const LAS f32x4*)(p_ + 2 * CH * 64); Y[7] = *(const LAS f32x4*)(p_ + 2 * CH * 64 + 4); \
                    const float br_ = sc_[(s_)], kr_ = sc_[CH + (s_)]; \
                    f32x2 kk_[4], wr_[4], w_[4], b_[4], k_[4]; \
                    _Pragma("unroll") for (int h2 = 0; h2 < 2; ++h2) { \
                        kk_[2 * h2] = (f32x2){X[h2][0], X[h2][1]}; kk_[2 * h2 + 1] = (f32x2){X[h2][2], X[h2][3]}; \
                        wr_[2 * h2] = (f32x2){Y[0 + h2][0], Y[0 + h2][1]}; wr_[2 * h2 + 1] = (f32x2){Y[0 + h2][2], Y[0 + h2][3]}; \
                        w_[2 * h2] = (f32x2){Y[2 + h2][0], Y[2 + h2][1]}; w_[2 * h2 + 1] = (f32x2){Y[2 + h2][2], Y[2 + h2][3]}; \
                        b_[2 * h2] = (f32x2){Y[4 + h2][0], Y[4 + h2][1]}; b_[2 * h2 + 1] = (f32x2){Y[4 + h2][2], Y[4 + h2][3]}; \
                        k_[2 * h2] = (f32x2){Y[6 + h2][0], Y[6 + h2][1]}; k_[2 * h2 + 1] = (f32x2){Y[6 + h2][2], Y[6 + h2][3]}; } \
                    const f32x2 d0 = (st0[0] * kk_[0] + st0[1] * kk_[1]) + (st0[2] * kk_[2] + st0[3] * kk_[3]); \
                    const f32x2 d1 = (st1[0] * kk_[0] + st1[1] * kk_[1]) + (st1[2] * kk_[2] + st1[3] * kk_[3]); \
                    const f32x2 e0 = (st0[0] * wr_[0] + st0[1] * wr_[1]) + (st0[2] * wr_[2] + st0[3] * wr_[3]); \
                    const f32x2 e1 = (st1[0] * wr_[0] + st1[1] * wr_[1]) + (st1[2] * wr_[2] + st1[3] * wr_[3]); \
                    const float sa0 = -sum8(d0.x + d0.y), sa1 = -sum8(d1.x + d1.y), q0_ = sum8(e0.x + e0.y), q1_ = sum8(e1.x + e1.y); \
                    const float xv0 = X0, xv1 = X1; \
                    PRE; \
                    _Pragma("unroll") for (int i = 0; i < 4; ++i) { \
                        st0[i] = st0[i] * w_[i] + (b_[i] * sa0 + k_[i] * xv0); \
                        st1[i] = st1[i] * w_[i] + (b_[i] * sa1 + k_[i] * xv1); } \
                    if ((lane & 7) == 0) { ob[(s_) * 64 + v0] = q0_ + sa0 * br_ + xv0 * kr_; ob[(s_) * 64 + v1] = q1_ + sa1 * br_ + xv1 * kr_; } } while (0)
                __builtin_amdgcn_s_setprio(2);
                SCAN_LDK(Ka, Av0, Av1, 0);
#pragma unroll 1
                for (int s = 0; s < CH; s += 2) {
                    SCAN_STEP(Ka, Av0, Av1, s, SCAN_LDK(Kb, Bv0, Bv1, s + 1));
                    const int sn = (s + 2 < CH) ? s + 2 : CH - 1;
                    SCAN_STEP(Kb, Bv0, Bv1, s + 1, SCAN_LDK(Ka, Av0, Av1, sn));
                }
                __builtin_amdgcn_s_setprio(0);
#undef SCAN_LDK
#undef SCAN_STEP
            }
            __syncthreads();
          }
        } else {
          load_raw(0); prep(0); load_raw(1); load_gate(0);
          __syncthreads();
          for (int cc = 0; cc < SEQ / CH; ++cc) {
            if (cc > 0) { post(cc - 1); load_gate(cc); }
            asm volatile("" ::: "memory");
            if (cc + 1 < SEQ / CH) prep(cc + 1);
            if (cc + 2 < SEQ / CH) load_raw(cc + 2);
            __syncthreads();
          }
          post(SEQ / CH - 1);
        }
        __syncthreads();
    }
}

#define XB_TMO      128
#define XB_XCNT(j)  (256  + 64 * (j))
#define XB_XSUB(j)  (1280 + 64 * (j))
#define XB_XGEN(j)  (2304 + 64 * (j))
#define XB_TOP      3328
#define XB_TOPGEN   3392
#define XCD_BAR_WORDS 3456
#define XB_SPIN_CAP (1u << 22)
DEVINL unsigned xb_ld(unsigned* p) { return __hip_atomic_load(p, __ATOMIC_RELAXED, __HIP_MEMORY_SCOPE_AGENT); }
DEVINL unsigned xb_add(unsigned* p, unsigned v) { return __hip_atomic_fetch_add(p, v, __ATOMIC_RELAXED, __HIP_MEMORY_SCOPE_AGENT); }
DEVINL unsigned xb_xcc_id() { return (unsigned)__builtin_amdgcn_s_getreg((3 << 11) | 20) & 0xFu; }
#define XB_SPIN(cond, bar) do { unsigned _sp = 0; while (cond) { __builtin_amdgcn_s_sleep(1); \
    if ((++_sp & 255u) == 0u) { if (xb_ld(&(bar)[XB_TMO])) break; if (_sp > XB_SPIN_CAP) { atomicAdd(&(bar)[XB_TMO], 1u); break; } } } } while (0)
struct XcdBarrier { unsigned* bar; unsigned x; volatile LAS unsigned* st; };
DEVINL XcdBarrier xcd_barrier_post(unsigned* bar, volatile LAS unsigned* st) {
    XcdBarrier b; b.bar = bar; b.x = xb_xcc_id(); b.st = st;
    if (threadIdx.x == 0) (void)xb_add(&bar[XB_XCNT(b.x)], 1u);
    return b;
}
DEVINL void xcd_barrier_complete(unsigned* bar, unsigned x, unsigned& nloc, unsigned& nx) {
    const unsigned G = gridDim.x * gridDim.y * gridDim.z;
    unsigned sum, cnt, mine, sp = 0u;
    for (;;) {
        sum = 0u; cnt = 0u; mine = 0u;
#pragma unroll
        for (unsigned j = 0; j < 16; ++j) { const unsigned c = xb_ld(&bar[XB_XCNT(j)]); sum += c; cnt += (c > 0u) ? 1u : 0u; mine = (j == x) ? c : mine; }
        if (sum == G) break;
        __builtin_amdgcn_s_sleep(1);
        if ((++sp & 255u) == 0u) { if (xb_ld(&bar[XB_TMO])) break; if (sp > XB_SPIN_CAP) { atomicAdd(&bar[XB_TMO], 1u); break; } }
    }
    nloc = mine > 0u ? mine : 1u; nx = cnt > 0u ? cnt : 1u;
}
DEVINL void xcd_barrier(const XcdBarrier& b) {
    asm volatile("s_waitcnt vmcnt(0)" ::: "memory");
    __syncthreads();
    if (threadIdx.x == 0) {
        unsigned* bar = b.bar;
        __builtin_amdgcn_s_waitcnt(0);
        unsigned nloc = b.st[0], nx = b.st[1];
        if (nloc == 0u) { xcd_barrier_complete(bar, b.x, nloc, nx); b.st[0] = nloc; b.st[1] = nx; }
        const unsigned old = xb_add(&bar[XB_XSUB(b.x)], 1u);
        const unsigned gen = old / nloc;
        if (old + 1u == (gen + 1u) * nloc) {
            __builtin_amdgcn_fence(__ATOMIC_RELEASE, "agent");
            asm volatile("s_waitcnt vmcnt(0)" ::: "memory");
            const unsigned og = xb_add(&bar[XB_TOP], 1u);
            const unsigned tg = og / nx;
            if (og + 1u == (tg + 1u) * nx) xb_add(&bar[XB_TOPGEN], 1u);
            else XB_SPIN(xb_ld(&bar[XB_TOPGEN]) == tg, bar);
            __builtin_amdgcn_fence(__ATOMIC_ACQUIRE, "agent");
            xb_add(&bar[XB_XGEN(b.x)], 1u);
            asm volatile("s_waitcnt vmcnt(0)" ::: "memory");
        } else {
            XB_SPIN(xb_ld(&bar[XB_XGEN(b.x)]) == gen, bar);
            __builtin_amdgcn_fence(__ATOMIC_ACQUIRE, "agent");
            asm volatile("s_waitcnt vmcnt(0)" ::: "memory");
        }
    }
    __syncthreads();
}

#define CG_BARRIER() do { \
    asm volatile("s_waitcnt vmcnt(0) lgkmcnt(0)" ::: "memory"); \
    grid.sync(); \
    if (threadIdx.x < 64) { __builtin_amdgcn_fence(__ATOMIC_ACQUIRE, "agent"); asm volatile("s_waitcnt vmcnt(0) lgkmcnt(0)" ::: "memory"); } \
    __syncthreads(); } while (0)
#define GRID_BARRIER() xcd_barrier(xb)
#define PHASE_END(n) GRID_BARRIER()

__global__ void __launch_bounds__(512) fwd_megakernel(Params p) {
    extern __shared__ __attribute__((aligned(16))) unsigned char shm[];
    LAS unsigned char* lds = (LAS unsigned char*)shm;
    cg::grid_group grid = cg::this_grid();
    __shared__ unsigned xb_words[4];
    if (threadIdx.x < 4) xb_words[threadIdx.x] = 0u;
    __syncthreads();
    const XcdBarrier xb = xcd_barrier_post((unsigned*)(p.ws + OFF_BAR), (volatile LAS unsigned*)xb_words);
    unsigned char* ws = p.ws;
    bf16_t* const Wi = (bf16_t*)(ws + OFF_WIN);
    bf16_t* const h = (bf16_t*)(ws + DY_H);
    const float* x_in = p.in[0];
    float* xres = p.out;

    { int rot = 0; conv_range<0, 20>(lds, p, rot); }
    zero_lora((bf16_t*)(ws + OFF_WLORA));
    rmsnorm_rows(x_in, p.in[3], h, T);
    rmsnorm_rows(p.in[1], p.in[32], (bf16_t*)(ws + DY_MEMN), NMEMT);
    cs_table(p.pos, (f32x2*)(ws + OFF_CS));
    CG_BARRIER();
    { EpiSwiGLU e; e.O = (bf16_t*)(ws + DY_ACT); run_gemm(lds, h, D, (bf16_t*)(ws + OFF_WFFGU), D, T, 11008, D, 0, e); }
    { EpiBf16 e; e.O = (bf16_t*)(ws + OFF_KMEM); e.ldc = 1024; run_gemm(lds, (bf16_t*)(ws + DY_MEMN), D, (bf16_t*)(ws + OFF_WCKVK), D, NMEMT, 1024, D, 128, e); }
    { EpiBf16 e; e.O = (bf16_t*)(ws + OFF_VTMEM); e.ldc = NMEMT; run_gemm(lds, (bf16_t*)(ws + OFF_WCKVV), D, (bf16_t*)(ws + DY_MEMN), D, 1024, NMEMT, D, 64, e); }
    PHASE_END(1);
    { EpiBf16NT e; e.O = (bf16_t*)(ws + DY_YFFN); e.ldc = D; run_gemm(lds, (bf16_t*)(ws + DY_ACT), DFF, (bf16_t*)(ws + OFF_WFFD), DFF, T, D, DFF, 0, e); }
    PHASE_END(2);
    row_update((bf16_t*)(ws + DY_YFFN), x_in, xres, p.in[4], 0.5f, p.in[8], h);
    { int rot = 0; conv_range<20, 23>(lds, p, rot); }
    PHASE_END(3);
    { EpiIn e; e.Prwkv = (bf16_t*)(ws + DY_PRWKV); e.G = (bf16_t*)(ws + DY_GATES); e.Pmla = (bf16_t*)(ws + DY_PMLA); e.krraw = (float*)(ws + DY_KRRAW); e.bgate = p.in[11];
      run_gemm(lds, h, D, Wi, D, T, 8448, D, 0, e); }
    PHASE_END(4);
    mix_prep((bf16_t*)(ws + DY_PMLA), p.in[12], p.in[14], (float*)(ws + DY_KRRAW), (f32x2*)(ws + OFF_CS), (bf16_t*)(ws + OFF_KR), (bf16_t*)(ws + DY_PRWKV), p.in[17], (bf16_t*)(ws + DY_LIN));
    PHASE_END(5);
    { EpiBf16 e; e.O = (bf16_t*)(ws + DY_Q); e.ldc = 1536; run_gemm(lds, (bf16_t*)(ws + DY_PMLA), 768, (bf16_t*)(ws + OFF_WUQ), 512, T, 1536, 512, 0, e); }
    { EpiBf16 e; e.O = (bf16_t*)(ws + DY_KN); e.ldc = 1024; run_gemm(lds, (bf16_t*)(ws + DY_PMLA) + 512, 768, (bf16_t*)(ws + OFF_WUKVK), 256, T, 1024, 256, 0, e); }
    { EpiBf16 e; e.O = (bf16_t*)(ws + DY_VT); e.ldc = T; run_gemm(lds, (bf16_t*)(ws + OFF_WUKVV), 256, (bf16_t*)(ws + DY_PMLA) + 512, 768, 1024, T, 256, 0, e); }
    PHASE_END(6);
    mla_attention(lds, (bf16_t*)(ws + DY_Q), (bf16_t*)(ws + DY_KN), (bf16_t*)(ws + OFF_KR), (bf16_t*)(ws + DY_VT), (bf16_t*)(ws + DY_OMLA), (f32x2*)(ws + OFF_CS));
    PHASE_END(7);
    { EpiLora<0> e; e.O = (bf16_t*)(ws + DY_U); e.bias = p.in[18]; run_gemm(lds, (bf16_t*)(ws + DY_LIN), 256, (bf16_t*)(ws + OFF_WLORA), 256, T, 1024, 256, 0, e); }
    { EpiLora<1> e; e.O = (bf16_t*)(ws + DY_A); e.bias = p.in[20]; run_gemm(lds, (bf16_t*)(ws + DY_LIN), 256, (bf16_t*)(ws + OFF_WLORA) + (size_t)1024 * 256, 256, T, 1024, 256, 0, e); }
    { EpiLora<2> e; e.O = (bf16_t*)(ws + DY_G); e.bias = nullptr; run_gemm(lds, (bf16_t*)(ws + DY_LIN), 256, (bf16_t*)(ws + OFF_WLORA) + (size_t)2048 * 256, 256, T, 1024, 256, 0, e); }
    PHASE_END(8);
    rwkv_scan(lds, (bf16_t*)(ws + DY_PRWKV), (bf16_t*)(ws + DY_A), (bf16_t*)(ws + DY_G), (bf16_t*)(ws + DY_U), p.in[18], p.in[20], p.in[17], p.in[23], p.in[24], p.in[25], p.in[26], p.in[27], (bf16_t*)(ws + DY_ORWKV));
    PHASE_END(9);
    { EpiGate<0> e; e.G = (bf16_t*)(ws + DY_GATES); e.Mg = (bf16_t*)(ws + DY_MERGED); run_gemm(lds, (bf16_t*)(ws + DY_OMLA), 1024, (bf16_t*)(ws + OFF_WOA), 1024, T, D, 1024, 0, e); }
    PHASE_END(10);
    { EpiGate<1> e; e.G = (bf16_t*)(ws + DY_GATES) + 2048; e.Mg = (bf16_t*)(ws + DY_MERGED); run_gemm(lds, (bf16_t*)(ws + DY_ORWKV), 1024, (bf16_t*)(ws + OFF_WOB), 1024, T, D, 1024, 0, e); }
    PHASE_END(11);
    { EpiBf16NT e; e.O = (bf16_t*)(ws + DY_Y); e.ldc = D; run_gemm(lds, (bf16_t*)(ws + DY_MERGED), D, (bf16_t*)(ws + OFF_WO), D, T, D, D, 0, e); }
    PHASE_END(12);
    row_update((bf16_t*)(ws + DY_Y), xres, xres, p.in[9], 1.0f, p.in[30], h);
    PHASE_END(13);
    { EpiBf16 e; e.O = (bf16_t*)(ws + DY_QX); e.ldc = 1024; run_gemm(lds, h, D, (bf16_t*)(ws + OFF_WCQ), D, T, 1024, D, 0, e); }
    PHASE_END(14);
    mem_attention(lds, (bf16_t*)(ws + DY_QX), (bf16_t*)(ws + OFF_KMEM), (bf16_t*)(ws + OFF_VTMEM), (bf16_t*)(ws + DY_OX));
    PHASE_END(15);
    { EpiBf16NT e; e.O = (bf16_t*)(ws + DY_Y); e.ldc = D; run_gemm(lds, (bf16_t*)(ws + DY_OX), 1024, (bf16_t*)(ws + OFF_WCO), 1024, T, D, 1024, 0, e); }
    PHASE_END(16);
    row_update((bf16_t*)(ws + DY_Y), xres, xres, p.in[31], 1.0f, p.in[36], h);
    PHASE_END(17);
    { EpiSwiGLU e; e.O = (bf16_t*)(ws + DY_ACT); run_gemm(lds, h, D, (bf16_t*)(ws + OFF_WFFGU), D, T, 11008, D, 0, e); }
    PHASE_END(18);
    { EpiBf16NT e; e.O = (bf16_t*)(ws + DY_YFFN); e.ldc = D; run_gemm(lds, (bf16_t*)(ws + DY_ACT), DFF, (bf16_t*)(ws + OFF_WFFD), DFF, T, D, DFF, 0, e); }
    PHASE_END(19);
    row_update((bf16_t*)(ws + DY_YFFN), xres, xres, p.in[37], 0.5f, nullptr, nullptr);
}

static ConvJob mkjob(const float* src, bf16_t* dst, int K, int ldn, int c0, int ncols, int gs, int sstride, int dstride, int ldk) {
    ConvJob j; j.src = src; j.dst = dst; j.K = K; j.ldn = ldn; j.c0 = c0; j.ncols = ncols; j.gs = gs; j.sstride = sstride; j.dstride = dstride; j.ldk = ldk; return j;
}

extern "C" void kernel_launch(void* const* d_in, const int* in_sizes, int n_in, void* d_out, int out_size, void* d_ws, size_t ws_size, hipStream_t stream) {
    static int grid_blocks = 0;
    if (grid_blocks == 0) {
        if (n_in != 41 || out_size != T * D || ws_size < WS_NEED) { fprintf(stderr, "kernel_launch: unexpected shapes (n_in %d out %d ws %zu need %zu)\n", n_in, out_size, ws_size, (size_t)WS_NEED); grid_blocks = -1; return; }
        int dev = 0, cus = 0, per_cu = 0;
        hipGetDevice(&dev);
        hipDeviceGetAttribute(&cus, hipDeviceAttributeMultiprocessorCount, dev);
        if (hipFuncSetAttribute((const void*)fwd_megakernel, hipFuncAttributeMaxDynamicSharedMemorySize, LDS_BYTES) != hipSuccess) { fprintf(stderr, "kernel_launch: hipFuncSetAttribute failed\n"); grid_blocks = -1; return; }
        if (hipOccupancyMaxActiveBlocksPerMultiprocessor(&per_cu, (const void*)fwd_megakernel, 512, LDS_BYTES) != hipSuccess || per_cu < 1) { fprintf(stderr, "kernel_launch: occupancy query failed (%d)\n", per_cu); (void)hipGetLastError(); per_cu = 1; }
        grid_blocks = cus * per_cu;
    }
    if (grid_blocks < 0) return;
    Params p{};
    for (int i = 0; i < 41; ++i) p.in[i] = (const float*)d_in[i];
    p.pos = (const int*)d_in[2]; p.out = (float*)d_out; p.ws = (unsigned char*)d_ws;
    unsigned char* ws = (unsigned char*)d_ws;
    int n = 0;
    const float* w_in = (const float*)d_in[10];
    p.jobs[n++] = mkjob(w_in, (bf16_t*)(ws + OFF_WIN), 2048, 8256, 832, 3328, 3328, 0, 0, 2048);
    p.jobs[n++] = mkjob(w_in, (bf16_t*)(ws + OFF_WIN) + (size_t)3328 * 2048, 2048, 8256, 4160, 4096, 4096, 0, 0, 2048);
    p.jobs[n++] = mkjob(w_in, (bf16_t*)(ws + OFF_WIN) + (size_t)7424 * 2048, 2048, 8256, 0, 768, 768, 0, 0, 2048);
    p.jobs[n++] = mkjob(w_in, (bf16_t*)(ws + OFF_WIN) + (size_t)8192 * 2048, 2048, 8256, 768, 64, 64, 0, 0, 2048);
    p.jobs[n++] = mkjob((const float*)d_in[13], (bf16_t*)(ws + OFF_WUQ), 512, 1536, 0, 1536, 1536, 0, 0, 512);
    p.jobs[n++] = mkjob((const float*)d_in[15], (bf16_t*)(ws + OFF_WUKVK), 256, 2048, 0, 1024, 128, 256, 128, 256);
    p.jobs[n++] = mkjob((const float*)d_in[15], (bf16_t*)(ws + OFF_WUKVV), 256, 2048, 128, 1024, 128, 256, 128, 256);
    p.jobs[n++] = mkjob((const float*)d_in[19], (bf16_t*)(ws + OFF_WLORA), 64, 1024, 0, 1024, 1024, 0, 0, 256);
    p.jobs[n++] = mkjob((const float*)d_in[21], (bf16_t*)(ws + OFF_WLORA) + (size_t)1024 * 256 + 64, 64, 1024, 0, 1024, 1024, 0, 0, 256);
    p.jobs[n++] = mkjob((const float*)d_in[22], (bf16_t*)(ws + OFF_WLORA) + (size_t)2048 * 256 + 128, 128, 1024, 0, 1024, 1024, 0, 0, 256);
    p.jobs[n++] = mkjob((const float*)d_in[16], (bf16_t*)(ws + OFF_WOA), 1024, 2048, 0, 2048, 2048, 0, 0, 1024);
    p.jobs[n++] = mkjob((const float*)d_in[28], (bf16_t*)(ws + OFF_WOB), 1024, 2048, 0, 2048, 2048, 0, 0, 1024);
    p.jobs[n++] = mkjob((const float*)d_in[29], (bf16_t*)(ws + OFF_WO), 2048, 2048, 0, 2048, 2048, 0, 0, 2048);
    p.jobs[n++] = mkjob((const float*)d_in[33], (bf16_t*)(ws + OFF_WCQ), 2048, 1024, 0, 1024, 1024, 0, 0, 2048);
    p.jobs[n++] = mkjob((const float*)d_in[34], (bf16_t*)(ws + OFF_WCKVK), 2048, 2048, 0, 1024, 256, 512, 256, 2048);
    p.jobs[n++] = mkjob((const float*)d_in[34], (bf16_t*)(ws + OFF_WCKVV), 2048, 2048, 256, 1024, 256, 512, 256, 2048);
    p.jobs[n++] = mkjob((const float*)d_in[35], (bf16_t*)(ws + OFF_WCO), 1024, 2048, 0, 2048, 2048, 0, 0, 1024);
    p.jobs[n++] = mkjob((const float*)d_in[5], (bf16_t*)(ws + OFF_WFFGU), 2048, 5504, 0, 5504, 128, 128, 256, 2048);
    p.jobs[n++] = mkjob((const float*)d_in[6], (bf16_t*)(ws + OFF_WFFGU) + (size_t)128 * 2048, 2048, 5504, 0, 5504, 128, 128, 256, 2048);
    p.jobs[n++] = mkjob((const float*)d_in[7], (bf16_t*)(ws + OFF_WFFD), 5504, 2048, 0, 2048, 2048, 0, 0, 5504);
    p.jobs[n++] = mkjob((const float*)d_in[38], (bf16_t*)(ws + OFF_WFFGU), 2048, 5504, 0, 5504, 128, 128, 256, 2048);
    p.jobs[n++] = mkjob((const float*)d_in[39], (bf16_t*)(ws + OFF_WFFGU) + (size_t)128 * 2048, 2048, 5504, 0, 5504, 128, 128, 256, 2048);
    p.jobs[n++] = mkjob((const float*)d_in[40], (bf16_t*)(ws + OFF_WFFD), 5504, 2048, 0, 2048, 2048, 0, 0, 5504);
    if (hipMemsetAsync((unsigned char*)d_ws + OFF_BAR, 0, XCD_BAR_WORDS * sizeof(unsigned), stream) != hipSuccess) { fprintf(stderr, "kernel_launch: memset of barrier words failed\n"); return; }
    void* args[] = {&p};
    hipError_t e = hipLaunchCooperativeKernel((const void*)fwd_megakernel, dim3(grid_blocks), dim3(512), args, LDS_BYTES, stream);
    if (e != hipSuccess) fprintf(stderr, "cooperative launch failed: %s (grid %d)\n", hipGetErrorString(e), grid_blocks);
}
```

```cpp
#include <hip/hip_runtime.h>
#include <hip/hip_cooperative_groups.h>
#include <cstdio>
namespace cg = cooperative_groups;


#define DEVINL __device__ __forceinline__
#define LAS __attribute__((address_space(3)))
typedef unsigned short bf16_t;
typedef short bf16x8 __attribute__((ext_vector_type(8)));
typedef float f32x4 __attribute__((ext_vector_type(4)));
typedef float f32x2 __attribute__((ext_vector_type(2)));
typedef unsigned u32x4 __attribute__((ext_vector_type(4)));
typedef unsigned u32x2 __attribute__((ext_vector_type(2)));

constexpr int T = 32768, D = 2048, DFF = 5504, SEQ = 2048, NB = 16, NMEMT = 4096;
constexpr int LDS_BYTES = 147456;

constexpr size_t MiB = 1048576;
constexpr size_t OFF_WIN = 0;
constexpr size_t OFF_WUQ = OFF_WIN + (size_t)8448 * 2048 * 2;
constexpr size_t OFF_WUKVK = OFF_WUQ + (size_t)1536 * 512 * 2;
constexpr size_t OFF_WUKVV = OFF_WUKVK + (size_t)1024 * 256 * 2;
constexpr size_t OFF_WLORA = OFF_WUKVV + (size_t)1024 * 256 * 2;
constexpr size_t OFF_WOA = OFF_WLORA + (size_t)3072 * 256 * 2;
constexpr size_t OFF_WOB = OFF_WOA + (size_t)2048 * 1024 * 2;
constexpr size_t OFF_WO = OFF_WOB + (size_t)2048 * 1024 * 2;
constexpr size_t OFF_WCQ = OFF_WO + (size_t)2048 * 2048 * 2;
constexpr size_t OFF_WCKVK = OFF_WCQ + (size_t)1024 * 2048 * 2;
constexpr size_t OFF_WCKVV = OFF_WCKVK + (size_t)1024 * 2048 * 2;
constexpr size_t OFF_WCO = OFF_WCKVV + (size_t)1024 * 2048 * 2;
constexpr size_t OFF_WFFGU = OFF_WCO + (size_t)2048 * 1024 * 2;
constexpr size_t OFF_WFFD = OFF_WFFGU + (size_t)11008 * 2048 * 2;
constexpr size_t OFF_KMEM = OFF_WFFD + (size_t)2048 * 5504 * 2;
constexpr size_t OFF_VTMEM = OFF_KMEM + (size_t)4096 * 1024 * 2;
constexpr size_t OFF_KR = OFF_VTMEM + (size_t)1024 * 4096 * 2;
constexpr size_t OFF_CS = OFF_KR + (size_t)T * 64 * 2;
constexpr size_t OFF_DYN = ((OFF_CS + (size_t)T * 32 * 8) + MiB - 1) / MiB * MiB;
constexpr size_t DY_H = OFF_DYN + 0 * MiB;
constexpr size_t DY_ACT = OFF_DYN + 128 * MiB;
constexpr size_t DY_YFFN = OFF_DYN + 472 * MiB;
constexpr size_t DY_MEMN = OFF_DYN + 728 * MiB;
constexpr size_t DY_GATES = OFF_DYN + 128 * MiB;
constexpr size_t DY_PRWKV = OFF_DYN + 384 * MiB;
constexpr size_t DY_PMLA = OFF_DYN + 592 * MiB;
constexpr size_t DY_LIN = OFF_DYN + 640 * MiB;
constexpr size_t DY_Q = OFF_DYN + 0 * MiB;
constexpr size_t DY_KN = OFF_DYN + 656 * MiB;
constexpr size_t DY_VT = OFF_DYN + 720 * MiB;
constexpr size_t DY_OMLA = OFF_DYN + 784 * MiB;
constexpr size_t DY_KRRAW = OFF_DYN + 848 * MiB;
constexpr size_t DY_A = OFF_DYN + 0 * MiB;
constexpr size_t DY_G = OFF_DYN + 64 * MiB;
constexpr size_t DY_U = OFF_DYN + 656 * MiB;
constexpr size_t DY_ORWKV = OFF_DYN + 720 * MiB;
constexpr size_t DY_MERGED = OFF_DYN + 384 * MiB;
constexpr size_t DY_Y = OFF_DYN + 128 * MiB;
constexpr size_t DY_QX = OFF_DYN + 512 * MiB;
constexpr size_t DY_OX = OFF_DYN + 576 * MiB;
constexpr size_t OFF_BAR = OFF_DYN + 856 * MiB;
constexpr size_t WS_NEED = OFF_BAR + 65536;

struct ConvJob { const float* src; bf16_t* dst; int K, ldn, c0, ncols, gs, sstride, dstride, ldk; };
constexpr int NJOBS = 23;
struct Params {
    const float* in[41];
    const int* pos;
    float* out;
    unsigned char* ws;
    ConvJob jobs[NJOBS];
};

typedef __bf16 bf16x2_t __attribute__((ext_vector_type(2)));
DEVINL unsigned cvt_pk_bf16(float lo, float hi) { const f32x2 v = {lo, hi}; return __builtin_bit_cast(unsigned, __builtin_convertvector(v, bf16x2_t)); }
DEVINL int opaque_tid() { int t = threadIdx.x; asm volatile("" : "+v"(t)); return t; }
DEVINL float bflo(unsigned w) { return __uint_as_float(w << 16); }
DEVINL float bfhi(unsigned w) { return __uint_as_float(w & 0xffff0000u); }
DEVINL float wave_sum(float v) {
#pragma unroll
    for (int o = 32; o >= 1; o >>= 1) v += __shfl_xor(v, o);
    return v;
}
DEVINL float sigmoidf_(float z) { return __builtin_amdgcn_rcpf(1.0f + __expf(-z)); }
DEVINL void store8(bf16_t* p, f32x4 v0, f32x4 v1) {
    u32x4 w; w.x = cvt_pk_bf16(v0[0], v0[1]); w.y = cvt_pk_bf16(v0[2], v0[3]); w.z = cvt_pk_bf16(v1[0], v1[1]); w.w = cvt_pk_bf16(v1[2], v1[3]);
    *(u32x4*)p = w;
}
DEVINL void store8_nt(bf16_t* p, f32x4 v0, f32x4 v1) {
    u32x4 w; w.x = cvt_pk_bf16(v0[0], v0[1]); w.y = cvt_pk_bf16(v0[2], v0[3]); w.z = cvt_pk_bf16(v1[0], v1[1]); w.w = cvt_pk_bf16(v1[2], v1[3]);
    __builtin_nontemporal_store(w, (u32x4*)p);
}
DEVINL void unpack8(u32x4 w, float (&f)[8]) {
    f[0] = bflo(w.x); f[1] = bfhi(w.x); f[2] = bflo(w.y); f[3] = bfhi(w.y); f[4] = bflo(w.z); f[5] = bfhi(w.z); f[6] = bflo(w.w); f[7] = bfhi(w.w);
}
template <int CTRL> DEVINL float dppf(float x) { return __int_as_float(__builtin_amdgcn_update_dpp(0, __float_as_int(x), CTRL, 0xF, 0xF, true)); }
DEVINL float sum8(float v) { v += dppf<0xB1>(v); v += dppf<0x4E>(v); v += dppf<0x141>(v); return v; }

constexpr int BM = 256, BK = 64, HALF = 128, HTB = HALF * BK * 2, NXCD = 8, WGM = 8;
__host__ __device__ __forceinline__ int lds_byte(int r, int c) { const int st = (r >> 4) * 2 + (c >> 5), rr = r & 15, cc = c & 31, ob = rr * 64 + cc * 2; return st * 1024 + (ob ^ (((ob >> 9) & 1) << 5)); }
__host__ __device__ __forceinline__ void stage_rc(int b, int& R, int& C) { const int st = b / 1024, sb = b % 1024, swz = sb ^ (((sb >> 9) & 1) << 5); R = (st >> 1) * 16 + swz / 64; C = (st & 1) * 32 + (swz % 64) / 2; }
__host__ __device__ __forceinline__ int perm32(int rho) { const int n = rho >> 4, i = rho & 15; return 8 * (i >> 2) + 4 * n + (i & 3); }

struct Unit { int pm, pn; };
struct Gemm { const bf16_t* A; const bf16_t* Bt; int M, N, K, lda, ldb; };

struct Order {
    int nM, nN, nwg, G, c;
    DEVINL void init(int M, int N, int G_, int c_) { nM = M / BM; nN = N / BM; nwg = nM * nN; G = G_; c = c_; }
    DEVINL bool next(int i, Unit& u) const {
        const long L = (long)i * G + c; if (L >= nwg) return false;
        int wgid = (int)L; { const int q = nwg / NXCD, r = nwg % NXCD, xcd = wgid % NXCD, off = wgid / NXCD; wgid = (xcd < r ? xcd * (q + 1) : r * (q + 1) + (xcd - r) * q) + off; }
        const int nig = WGM * nN, gid = wgid / nig, fm = gid * WGM, gsz = (nM - fm) < WGM ? (nM - fm) : WGM;
        u.pm = fm + ((wgid % nig) % gsz); u.pn = (wgid % nig) / gsz; return true;
    }
};

template <class Epi>
DEVINL void gemm_phase(LAS unsigned char* lds, const Gemm g, const Order& S, const Epi& E) {
    const int tid = opaque_tid(), wid = __builtin_amdgcn_readfirstlane(tid >> 6), lane = tid & 63, wr = wid >> 2, wc = wid & 3, fr = lane & 15, fq = lane >> 4;
    const int K = g.K, nt = K / BK;
    unsigned voffA[2], voffB[2];
#pragma unroll
    for (int i = 0; i < 2; ++i) { int R, C; stage_rc(tid * 16 + i * 8192, R, C); const int Rb = Epi::PERM ? ((R & ~31) + perm32(R & 31)) : R;
        voffA[i] = (unsigned)(R * g.lda + C) * 2u; voffB[i] = (unsigned)(Rb * g.ldb + C) * 2u; }
    const size_t kstep = (size_t)(BK * 2);
    const size_t hstepA = (size_t)HALF * g.lda * 2, hstepB = (size_t)HALF * g.ldb * 2;
    const size_t tstepA = 2 * hstepA, tstepB = 2 * hstepB;
    const unsigned ldsw = (unsigned)wid * 1024u;
    const int aoff = lds_byte(wr * 64 + fr, fq * 8), boff = lds_byte(wc * 32 + fr, fq * 8);
#define PG8_SA(b, h) (((b) * 2 + (h)) * HTB)
#define PG8_SB(b, h) ((4 + (b) * 2 + (h)) * HTB)
#define PG8_STAGE(bufoff, gbase, voff) do { _Pragma("unroll") for (int _i = 0; _i < 2; ++_i) \
        __builtin_amdgcn_global_load_lds((const unsigned*)((const char*)(gbase) + (voff)[_i]), (LAS unsigned*)(lds + (bufoff) + ldsw + _i * 8192), 16, 0, 0); } while (0)
#define PG8_LDA(dst, b, h) do { _Pragma("unroll") for (int m = 0; m < 4; ++m) _Pragma("unroll") for (int k = 0; k < 2; ++k) dst[m][k] = *(const LAS bf16x8*)(lds + PG8_SA(b, h) + aoff + m * 2048 + k * 1024); } while (0)
#define PG8_LDB(dst, b, h) do { _Pragma("unroll") for (int n = 0; n < 2; ++n) _Pragma("unroll") for (int k = 0; k < 2; ++k) dst[n][k] = *(const LAS bf16x8*)(lds + PG8_SB(b, h) + boff + n * 2048 + k * 1024); } while (0)
#define PG8_MMA(ai, bj, At, Bt) do { __builtin_amdgcn_s_setprio(1); _Pragma("unroll") for (int m = 0; m < 4; ++m) _Pragma("unroll") for (int n = 0; n < 2; ++n) _Pragma("unroll") for (int k = 0; k < 2; ++k) \
        acc[ai][bj][m][n] = __builtin_amdgcn_mfma_f32_16x16x32_bf16(Bt[n][k], At[m][k], acc[ai][bj][m][n], 0, 0, 0); __builtin_amdgcn_s_setprio(0); } while (0)
#define PG8_WAIT_V(n) asm volatile("s_waitcnt vmcnt(" #n ")" ::: "memory")
#define PG8_WAIT_L(n) asm volatile("s_waitcnt lgkmcnt(" #n ")" ::: "memory")
#define PG8_BAR __builtin_amdgcn_s_barrier()
#define PG8_SCHED __builtin_amdgcn_sched_barrier(0)
    Unit cur, nxt; int ui = 0;
    if (!S.next(0, cur)) return;
    f32x4 acc[2][2][4][2];
#pragma unroll
    for (int a = 0; a < 2; ++a)
#pragma unroll
        for (int b = 0; b < 2; ++b)
#pragma unroll
            for (int m = 0; m < 4; ++m)
#pragma unroll
                for (int n = 0; n < 2; ++n) acc[a][b][m][n] = (f32x4){0.f, 0.f, 0.f, 0.f};
    bf16x8 At[4][2], B0[2][2], B1[2][2];
    const char* cA = (const char*)g.A + (size_t)cur.pm * tstepA; const char* cB = (const char*)g.Bt + (size_t)cur.pn * tstepB;
    PG8_STAGE(PG8_SB(0, 0), cB, voffB); PG8_STAGE(PG8_SA(0, 0), cA, voffA); PG8_STAGE(PG8_SB(0, 1), cB + hstepB, voffB); PG8_STAGE(PG8_SA(0, 1), cA + hstepA, voffA);
    if (wr == 1) PG8_BAR;
    PG8_WAIT_V(4); PG8_BAR;
    PG8_STAGE(PG8_SB(1, 0), cB + kstep, voffB); PG8_STAGE(PG8_SA(1, 0), cA + kstep, voffA); PG8_STAGE(PG8_SB(1, 1), cB + hstepB + kstep, voffB);
    PG8_WAIT_V(6); PG8_BAR;
    for (;;) {
        const bool has_next = S.next(ui + 1, nxt);
        const char* nA = has_next ? (const char*)g.A + (size_t)nxt.pm * tstepA : cA; const char* nB = has_next ? (const char*)g.Bt + (size_t)nxt.pn * tstepB : cB;
        for (int t = 0; t < nt; t += 2) {
            const bool last = (t == nt - 2);
            const char* a1 = cA + (size_t)(t + 1) * kstep;
            const char* a2 = last ? nA : cA + (size_t)(t + 2) * kstep; const char* b2 = last ? nB : cB + (size_t)(t + 2) * kstep;
            const char* a3 = a2 + kstep; const char* b3 = b2 + kstep;
            PG8_LDB(B0, 0, 0); PG8_SCHED; PG8_LDA(At, 0, 0); PG8_STAGE(PG8_SA(1, 1), a1 + hstepA, voffA);
            PG8_WAIT_L(8); PG8_BAR; PG8_WAIT_L(0); PG8_MMA(0, 0, At, B0); PG8_BAR; PG8_SCHED;
            PG8_LDB(B1, 0, 1); PG8_STAGE(PG8_SB(0, 0), b2, voffB);
            PG8_BAR; PG8_WAIT_L(0); PG8_MMA(0, 1, At, B1); PG8_BAR;
            PG8_LDA(At, 0, 1); PG8_STAGE(PG8_SA(0, 0), a2, voffA);
            PG8_BAR; PG8_WAIT_L(0); PG8_MMA(1, 0, At, B0); PG8_BAR; PG8_SCHED;
            PG8_STAGE(PG8_SB(0, 1), b2 + hstepB, voffB);
            PG8_WAIT_V(6); PG8_BAR; PG8_MMA(1, 1, At, B1); PG8_BAR;
            PG8_LDB(B0, 1, 0); PG8_SCHED; PG8_LDA(At, 1, 0); PG8_STAGE(PG8_SA(0, 1), a2 + hstepA, voffA);
            PG8_WAIT_L(8); PG8_BAR; PG8_WAIT_L(0); PG8_MMA(0, 0, At, B0); PG8_BAR; PG8_SCHED;
            PG8_LDB(B1, 1, 1); PG8_STAGE(PG8_SB(1, 0), b3, voffB);
            PG8_BAR; PG8_WAIT_L(0); PG8_MMA(0, 1, At, B1); PG8_BAR;
            PG8_LDA(At, 1, 1); PG8_STAGE(PG8_SA(1, 0), a3, voffA);
            PG8_BAR; PG8_WAIT_L(0); PG8_MMA(1, 0, At, B0); PG8_BAR; PG8_SCHED;
            PG8_STAGE(PG8_SB(1, 1), b3 + hstepB, voffB);
            PG8_WAIT_V(6); PG8_BAR; PG8_MMA(1, 1, At, B1); PG8_BAR;
        }
        E(acc, cur, wr, wc, fr, fq);
        if (!has_next) break;
#pragma unroll
        for (int a = 0; a < 2; ++a)
#pragma unroll
            for (int b = 0; b < 2; ++b)
#pragma unroll
                for (int m = 0; m < 4; ++m)
#pragma unroll
                    for (int n = 0; n < 2; ++n) acc[a][b][m][n] = (f32x4){0.f, 0.f, 0.f, 0.f};
        cur = nxt; cA = nA; cB = nB; ++ui;
    }
    PG8_WAIT_V(0);
    if (wr == 0) PG8_BAR;
    PG8_BAR;
#undef PG8_SA
#undef PG8_SB
#undef PG8_STAGE
#undef PG8_LDA
#undef PG8_LDB
#undef PG8_MMA
#undef PG8_WAIT_V
#undef PG8_WAIT_L
#undef PG8_BAR
#undef PG8_SCHED
}

typedef const f32x4 (&AccRef)[2][2][4][2];

struct EpiF32 {
    static constexpr bool PERM = false;
    float* C; int ldc;
    DEVINL void operator()(AccRef acc, const Unit& u, int wr, int wc, int fr, int fq) const {
        const int row0 = u.pm * BM + wr * 64 + fr, col0 = u.pn * BM + wc * 32 + 4 * fq;
#pragma unroll
        for (int ai = 0; ai < 2; ++ai)
#pragma unroll
            for (int m = 0; m < 4; ++m) { float* rowp = C + (size_t)(row0 + ai * HALF + m * 16) * ldc + col0;
#pragma unroll
                for (int bj = 0; bj < 2; ++bj)
#pragma unroll
                    for (int n = 0; n < 2; ++n) *(f32x4*)(rowp + bj * HALF + n * 16) = acc[ai][bj][m][n]; }
    }
};
struct EpiBf16 {
    static constexpr bool PERM = true;
    bf16_t* O; int ldc;
    DEVINL void operator()(AccRef acc, const Unit& u, int wr, int wc, int fr, int fq) const {
        const int row0 = u.pm * BM + wr * 64 + fr, col0 = u.pn * BM + wc * 32 + 8 * fq;
#pragma unroll
        for (int ai = 0; ai < 2; ++ai)
#pragma unroll
            for (int m = 0; m < 4; ++m) { bf16_t* rowp = O + (size_t)(row0 + ai * HALF + m * 16) * ldc + col0;
#pragma unroll
                for (int bj = 0; bj < 2; ++bj) store8(rowp + bj * HALF, acc[ai][bj][m][0], acc[ai][bj][m][1]); }
    }
};
struct EpiSwiGLU {
    static constexpr bool PERM = true;
    bf16_t* O;
    DEVINL void operator()(AccRef acc, const Unit& u, int wr, int wc, int fr, int fq) const {
        const int row0 = u.pm * BM + wr * 64 + fr, col0 = u.pn * HALF + wc * 32 + 8 * fq;
#pragma unroll
        for (int ai = 0; ai < 2; ++ai)
#pragma unroll
            for (int m = 0; m < 4; ++m) { bf16_t* rowp = O + (size_t)(row0 + ai * HALF + m * 16) * DFF + col0;
                f32x4 v[2];
#pragma unroll
                for (int n = 0; n < 2; ++n)
#pragma unroll
                    for (int j = 0; j < 4; ++j) { const float gt = acc[ai][0][m][n][j], up = acc[ai][1][m][n][j]; v[n][j] = gt * sigmoidf_(gt) * up; }
                store8_nt(rowp, v[0], v[1]); }
    }
};
struct EpiIn {
    static constexpr bool PERM = true;
    bf16_t* Prwkv; bf16_t* G; bf16_t* Pmla; float* krraw; const float* bgate;
    DEVINL void operator()(AccRef acc, const Unit& u, int wr, int wc, int fr, int fq) const {
        const int row0 = u.pm * BM + wr * 64 + fr, lc0 = wc * 32 + 8 * fq, pn = u.pn;
        if (pn >= 13 && pn < 29) {
            const int cg0 = (pn - 13) * BM + lc0;
            f32x4 bv[2][2];
#pragma unroll
            for (int bj = 0; bj < 2; ++bj)
#pragma unroll
                for (int n = 0; n < 2; ++n) bv[bj][n] = *(const f32x4*)(bgate + cg0 + bj * HALF + 4 * n);
#pragma unroll
            for (int ai = 0; ai < 2; ++ai)
#pragma unroll
                for (int m = 0; m < 4; ++m) { bf16_t* rowp = G + (size_t)(row0 + ai * HALF + m * 16) * 4096 + cg0;
#pragma unroll
                    for (int bj = 0; bj < 2; ++bj) { f32x4 v[2];
#pragma unroll
                        for (int n = 0; n < 2; ++n)
#pragma unroll
                            for (int j = 0; j < 4; ++j) v[n][j] = sigmoidf_(acc[ai][bj][m][n][j] + bv[bj][n][j]);
                        store8(rowp + bj * HALF, v[0], v[1]); } }
        } else if (pn < 32) {
            bf16_t* base = pn < 13 ? Prwkv + pn * BM : Pmla + (pn - 29) * BM; const int ld = pn < 13 ? 3328 : 768;
#pragma unroll
            for (int ai = 0; ai < 2; ++ai)
#pragma unroll
                for (int m = 0; m < 4; ++m) { bf16_t* rowp = base + (size_t)(row0 + ai * HALF + m * 16) * ld + lc0;
#pragma unroll
                    for (int bj = 0; bj < 2; ++bj) store8(rowp + bj * HALF, acc[ai][bj][m][0], acc[ai][bj][m][1]); }
        } else {
            if (wc < 2) {
#pragma unroll
                for (int ai = 0; ai < 2; ++ai)
#pragma unroll
                    for (int m = 0; m < 4; ++m) { float* rowp = krraw + (size_t)(row0 + ai * HALF + m * 16) * 64 + lc0;
                        *(f32x4*)rowp = acc[ai][0][m][0]; *(f32x4*)(rowp + 4) = acc[ai][0][m][1]; }
            }
        }
    }
};
template <int SEL> struct EpiLora {
    static constexpr bool PERM = true;
    bf16_t* O; const float* bias;
    DEVINL void operator()(AccRef acc, const Unit& u, int wr, int wc, int fr, int fq) const {
        const int row0 = u.pm * BM + wr * 64 + fr, c0 = u.pn * BM + wc * 32 + 8 * fq;
#pragma unroll
        for (int bj = 0; bj < 2; ++bj) {
            f32x4 bv[2];
#pragma unroll
            for (int n = 0; n < 2; ++n) bv[n] = (f32x4){0.f, 0.f, 0.f, 0.f};
#pragma unroll
            for (int ai = 0; ai < 2; ++ai)
#pragma unroll
                for (int m = 0; m < 4; ++m) { bf16_t* rowp = O + (size_t)(row0 + ai * HALF + m * 16) * 1024 + c0 + bj * HALF; f32x4 v[2];
#pragma unroll
                    for (int n = 0; n < 2; ++n)
#pragma unroll
                        for (int j = 0; j < 4; ++j) { const float z = acc[ai][bj][m][n][j] + bv[n][j]; v[n][j] = z; }
                    store8(rowp, v[0], v[1]); }
        }
    }
};
template <int MODE> struct EpiGate {
    static constexpr bool PERM = true;
    const bf16_t* G; bf16_t* Mg;
    DEVINL void operator()(AccRef acc, const Unit& u, int wr, int wc, int fr, int fq) const {
        const int row0 = u.pm * BM + wr * 64 + fr, col0 = u.pn * BM + wc * 32 + 8 * fq;
#pragma unroll
        for (int ai = 0; ai < 2; ++ai) {
            u32x4 gq[4][2], mq[4][2];
#pragma unroll
            for (int m = 0; m < 4; ++m)
#pragma unroll
                for (int bj = 0; bj < 2; ++bj) { const size_t r = (size_t)(row0 + ai * HALF + m * 16);
                    gq[m][bj] = __builtin_nontemporal_load((const u32x4*)(G + r * 4096 + col0 + bj * HALF));
                    if (MODE == 1) mq[m][bj] = *(const u32x4*)(Mg + r * 2048 + col0 + bj * HALF); }
#pragma unroll
            for (int m = 0; m < 4; ++m)
#pragma unroll
                for (int bj = 0; bj < 2; ++bj) { const size_t r = (size_t)(row0 + ai * HALF + m * 16);
                    float gf[8], of[8]; unpack8(gq[m][bj], gf); if (MODE == 1) unpack8(mq[m][bj], of);
                    f32x4 v[2];
#pragma unroll
                    for (int n = 0; n < 2; ++n)
#pragma unroll
                        for (int j = 0; j < 4; ++j) { float t = gf[n * 4 + j] * acc[ai][bj][m][n][j]; if (MODE == 1) t += of[n * 4 + j]; v[n][j] = t; }
                    store8(Mg + r * 2048 + col0 + bj * HALF, v[0], v[1]); }
        }
    }
};

template <class Epi>
DEVINL void run_gemm(LAS unsigned char* lds, const bf16_t* A, int lda, const bf16_t* Bt, int ldb, int M, int N, int K, int rot, const Epi& E) {
    asm volatile("" : "+s"(K));
    Gemm g; g.A = A; g.Bt = Bt; g.M = M; g.N = N; g.K = K; g.lda = lda; g.ldb = ldb;
    Order S; S.init(M, N, (int)gridDim.x, (int)((blockIdx.x + rot) % gridDim.x));
    gemm_phase<Epi>(lds, g, S, E);
}

DEVINL void conv_job(LAS unsigned char* lds, const ConvJob& j, int& rot) {
    constexpr int RS = 260;
    const int tid = opaque_tid();
    const int nkb = j.K >> 6, nnb = (j.ncols + 127) >> 7, ntiles = nkb * nnb;
    const int rk = tid >> 3, rc = (tid & 7) * 16;
    const int wn = tid >> 2, wk = (tid & 3) * 16;
    f32x4 v[4];
    auto gload = [&](int tile) {
        const int kb = tile / nnb, nb = tile - kb * nnb, col = nb * 128 + rc;
        if (col < j.ncols) { const int grp = col / j.gs, r = col - grp * j.gs;
            const float* sp = j.src + (size_t)(kb * 64 + rk) * j.ldn + j.c0 + grp * j.sstride + r;
#pragma unroll
            for (int i = 0; i < 4; ++i) v[i] = __builtin_nontemporal_load((const f32x4*)(sp + 4 * i)); }
        else {
#pragma unroll
            for (int i = 0; i < 4; ++i) v[i] = (f32x4){0.f, 0.f, 0.f, 0.f}; }
    };
    const int G_ = (int)gridDim.x; int tile = ((int)blockIdx.x + G_ - rot % G_) % G_; rot += ntiles;
    if (tile < ntiles) gload(tile);
    for (; tile < ntiles; tile += gridDim.x) {
        unsigned pk[8];
#pragma unroll
        for (int i = 0; i < 4; ++i) { pk[2 * i] = cvt_pk_bf16(v[i][0], v[i][1]); pk[2 * i + 1] = cvt_pk_bf16(v[i][2], v[i][3]); }
        LAS unsigned* wp = (LAS unsigned*)(lds + rk * RS + rc * 2);
#pragma unroll
        for (int i = 0; i < 8; ++i) wp[i] = pk[i];
        const int nxt = tile + (int)gridDim.x;
        if (nxt < ntiles) gload(nxt);
        __syncthreads();
        const int kb = tile / nnb, nb = tile - kb * nnb, col = nb * 128 + wn;
        unsigned short e[16];
#pragma unroll
        for (int i = 0; i < 16; ++i) e[i] = *(const LAS unsigned short*)(lds + (wk + i) * RS + wn * 2);
        if (col < j.ncols) { const int grp = col / j.gs, r = col - grp * j.gs;
            bf16_t* d = j.dst + (size_t)(grp * j.dstride + r) * j.ldk + kb * 64 + wk;
            u32x4 w0, w1;
            w0.x = e[0] | ((unsigned)e[1] << 16); w0.y = e[2] | ((unsigned)e[3] << 16); w0.z = e[4] | ((unsigned)e[5] << 16); w0.w = e[6] | ((unsigned)e[7] << 16);
            w1.x = e[8] | ((unsigned)e[9] << 16); w1.y = e[10] | ((unsigned)e[11] << 16); w1.z = e[12] | ((unsigned)e[13] << 16); w1.w = e[14] | ((unsigned)e[15] << 16);
            *(u32x4*)d = w0; *(u32x4*)(d + 8) = w1; }
        __syncthreads();
    }
}
template <int J, int E> DEVINL void conv_range(LAS unsigned char* lds, const Params& p, int& rot) {
    if constexpr (J < E) { conv_job(lds, p.jobs[J], rot); conv_range<J + 1, E>(lds, p, rot); }
}
DEVINL void zero_lora(bf16_t* W) {
    for (int idx = blockIdx.x * 512 + opaque_tid(); idx < 3072 * 32; idx += gridDim.x * 512) {
        const int row = idx >> 5, k8 = (idx & 31) * 8, sel = row >> 10;
        const bool data = sel == 0 ? (k8 < 64) : (sel == 1 ? (k8 >= 64 && k8 < 128) : (k8 >= 128));
        if (!data) *(u32x4*)(W + (size_t)row * 256 + k8) = (u32x4){0u, 0u, 0u, 0u};
    }
}

DEVINL void rmsnorm_rows(const float* x, const float* g, bf16_t* out, int rows) {
    const int tid_ = opaque_tid(), lane = tid_ & 63, gw = blockIdx.x * 8 + (tid_ >> 6), nw = gridDim.x * 8;
    for (int t = gw; t < rows; t += 2 * nw) {
        const bool two = (t + nw) < rows; const int tb = two ? t + nw : t;
        f32x4 va[8], vb[8]; float sa = 0.f, sb = 0.f;
#pragma unroll
        for (int j = 0; j < 8; ++j) { va[j] = __builtin_nontemporal_load((const f32x4*)(x + (size_t)t * D + (j * 64 + lane) * 4)); vb[j] = __builtin_nontemporal_load((const f32x4*)(x + (size_t)tb * D + (j * 64 + lane) * 4));
            sa += va[j][0] * va[j][0] + va[j][1] * va[j][1] + va[j][2] * va[j][2] + va[j][3] * va[j][3];
            sb += vb[j][0] * vb[j][0] + vb[j][1] * vb[j][1] + vb[j][2] * vb[j][2] + vb[j][3] * vb[j][3]; }
#pragma unroll
        for (int o = 32; o >= 1; o >>= 1) { sa += __shfl_xor(sa, o); sb += __shfl_xor(sb, o); }
        const float ra = rsqrtf(sa * (1.0f / D) + 1e-6f), rb = rsqrtf(sb * (1.0f / D) + 1e-6f);
#pragma unroll
        for (int j = 0; j < 8; ++j) { const f32x4 gg = *(const f32x4*)(g + (j * 64 + lane) * 4); u32x2 wa, wb;
            wa.x = cvt_pk_bf16(va[j][0] * ra * gg[0], va[j][1] * ra * gg[1]); wa.y = cvt_pk_bf16(va[j][2] * ra * gg[2], va[j][3] * ra * gg[3]);
            wb.x = cvt_pk_bf16(vb[j][0] * rb * gg[0], vb[j][1] * rb * gg[1]); wb.y = cvt_pk_bf16(vb[j][2] * rb * gg[2], vb[j][3] * rb * gg[3]);
            *(u32x2*)(out + (size_t)t * D + (j * 64 + lane) * 4) = wa;
            if (two) *(u32x2*)(out + (size_t)tb * D + (j * 64 + lane) * 4) = wb; }
    }
}
DEVINL void row_update(const bf16_t* y, const float* xin, float* xout, const float* gpost, float coef, const float* gpre, bf16_t* h) {
    const int tid_ = opaque_tid(), lane = tid_ & 63, gw = blockIdx.x * 8 + (tid_ >> 6), nw = gridDim.x * 8;
    for (int t = gw; t < T; t += 2 * nw) {
        const bool two = (t + nw) < T; const int tb = two ? t + nw : t;
        f32x4 va[8], vb[8], xa_[8], xb_[8]; float sa = 0.f, sb = 0.f;
#pragma unroll
        for (int j = 0; j < 8; ++j) {
            xa_[j] = __builtin_nontemporal_load((const f32x4*)(xin + (size_t)t * D + (j * 64 + lane) * 4)); xb_[j] = __builtin_nontemporal_load((const f32x4*)(xin + (size_t)tb * D + (j * 64 + lane) * 4)); }
#pragma unroll
        for (int j = 0; j < 8; ++j) {
            const u32x2 ya = __builtin_nontemporal_load((const u32x2*)(y + (size_t)t * D + (j * 64 + lane) * 4)), yb = __builtin_nontemporal_load((const u32x2*)(y + (size_t)tb * D + (j * 64 + lane) * 4));
            va[j] = (f32x4){bflo(ya.x), bfhi(ya.x), bflo(ya.y), bfhi(ya.y)}; vb[j] = (f32x4){bflo(yb.x), bfhi(yb.x), bflo(yb.y), bfhi(yb.y)};
            sa += va[j][0] * va[j][0] + va[j][1] * va[j][1] + va[j][2] * va[j][2] + va[j][3] * va[j][3];
            sb += vb[j][0] * vb[j][0] + vb[j][1] * vb[j][1] + vb[j][2] * vb[j][2] + vb[j][3] * vb[j][3]; }
#pragma unroll
        for (int o = 32; o >= 1; o >>= 1) { sa += __shfl_xor(sa, o); sb += __shfl_xor(sb, o); }
        const float ra = rsqrtf(sa * (1.0f / D) + 1e-6f) * coef, rb = rsqrtf(sb * (1.0f / D) + 1e-6f) * coef; float qa = 0.f, qb = 0.f;
#pragma unroll
        for (int j = 0; j < 8; ++j) { const f32x4 gg = *(const f32x4*)(gpost + (j * 64 + lane) * 4);
            const f32x4 xa = xa_[j], xb = xb_[j];
            va[j] = xa + va[j] * ra * gg; vb[j] = xb + vb[j] * rb * gg;
            qa += va[j][0] * va[j][0] + va[j][1] * va[j][1] + va[j][2] * va[j][2] + va[j][3] * va[j][3];
            qb += vb[j][0] * vb[j][0] + vb[j][1] * vb[j][1] + vb[j][2] * vb[j][2] + vb[j][3] * vb[j][3];
            __builtin_nontemporal_store(va[j], (f32x4*)(xout + (size_t)t * D + (j * 64 + lane) * 4));
            if (two) __builtin_nontemporal_store(vb[j], (f32x4*)(xout + (size_t)tb * D + (j * 64 + lane) * 4)); }
        if (h) {
#pragma unroll
            for (int o = 32; o >= 1; o >>= 1) { qa += __shfl_xor(qa, o); qb += __shfl_xor(qb, o); }
            const float r2a = rsqrtf(qa * (1.0f / D) + 1e-6f), r2b = rsqrtf(qb * (1.0f / D) + 1e-6f);
#pragma unroll
            for (int j = 0; j < 8; ++j) { const f32x4 gg = *(const f32x4*)(gpre + (j * 64 + lane) * 4); u32x2 wa, wb;
                wa.x = cvt_pk_bf16(va[j][0] * r2a * gg[0], va[j][1] * r2a * gg[1]); wa.y = cvt_pk_bf16(va[j][2] * r2a * gg[2], va[j][3] * r2a * gg[3]);
                wb.x = cvt_pk_bf16(vb[j][0] * r2b * gg[0], vb[j][1] * r2b * gg[1]); wb.y = cvt_pk_bf16(vb[j][2] * r2b * gg[2], vb[j][3] * r2b * gg[3]);
                *(u32x2*)(h + (size_t)t * D + (j * 64 + lane) * 4) = wa;
                if (two) *(u32x2*)(h + (size_t)tb * D + (j * 64 + lane) * 4) = wb; }
        }
    }
}
__device__ const double c_inv_freq[32] = {
    1.0, 0.7498942093324559, 0.5623413251903491, 0.4216965034285822, 0.31622776601683794, 0.23713737056616552, 0.1778279410038923, 0.1333521432163324,
    0.1, 0.07498942093324558, 0.05623413251903491, 0.04216965034285822, 0.03162277660168379, 0.023713737056616554, 0.01778279410038923, 0.01333521432163324,
    0.01, 0.007498942093324558, 0.005623413251903491, 0.004216965034285823, 0.0031622776601683794, 0.0023713737056616554, 0.0017782794100389228, 0.001333521432163324,
    0.001, 0.0007498942093324559, 0.0005623413251903491, 0.0004216965034285823, 0.00031622776601683794, 0.00023713737056616554, 0.00017782794100389227, 0.0001333521432163324};
DEVINL void cs_table(const int* pos, f32x2* cs) {
    for (int idx = blockIdx.x * 512 + opaque_tid(); idx < T * 32; idx += gridDim.x * 512) {
        const int t = idx >> 5, i = idx & 31;
        const double rev = (double)pos[t] * c_inv_freq[i] * 0.15915494309189535;
        const float fr = (float)(rev - floor(rev)) * 6.2831853071795865f;
        cs[idx] = (f32x2){__cosf(fr), __sinf(fr)};
    }
}
DEVINL void mix_prep(bf16_t* Pmla, const float* nq, const float* nkv, const float* krraw, const f32x2* cs, bf16_t* kr,
                     const bf16_t* Prwkv, const float* mu, bf16_t* lin) {
    const int tid_ = opaque_tid(), lane = tid_ & 63, gw = blockIdx.x * 8 + (tid_ >> 6), nw = gridDim.x * 8;
    const int col = 3072 + lane * 4;
    for (int t = gw; t < T; t += nw) {
        bf16_t* pr = Pmla + (size_t)t * 768;
        const u32x4 wq = *(const u32x4*)(pr + lane * 8); const u32x2 wkv = *(const u32x2*)(pr + 512 + lane * 4);
        const int l32 = lane & 31;
        const float x1 = krraw[(size_t)t * 64 + l32], x2 = krraw[(size_t)t * 64 + 32 + l32]; const f32x2 c = cs[(size_t)t * 32 + l32];
        const u32x2 cw = *(const u32x2*)(Prwkv + (size_t)t * 3328 + col);
        u32x2 pw = (u32x2){0u, 0u}; if ((t & (SEQ - 1)) != 0) pw = *(const u32x2*)(Prwkv + (size_t)(t - 1) * 3328 + col);
        float f[8]; unpack8(wq, f); float ssq = 0.f;
#pragma unroll
        for (int i = 0; i < 8; ++i) ssq += f[i] * f[i];
        const float f0 = bflo(wkv.x), f1 = bfhi(wkv.x), f2 = bflo(wkv.y), f3 = bfhi(wkv.y); float ssk = f0 * f0 + f1 * f1 + f2 * f2 + f3 * f3;
#pragma unroll
        for (int o = 32; o >= 1; o >>= 1) { ssq += __shfl_xor(ssq, o); ssk += __shfl_xor(ssk, o); }
        { const float rs = rsqrtf(ssq * (1.0f / 512) + 1e-6f);
            const f32x4 g0 = *(const f32x4*)(nq + lane * 8), g1 = *(const f32x4*)(nq + lane * 8 + 4);
            store8(pr + lane * 8, (f32x4){f[0] * rs * g0[0], f[1] * rs * g0[1], f[2] * rs * g0[2], f[3] * rs * g0[3]}, (f32x4){f[4] * rs * g1[0], f[5] * rs * g1[1], f[6] * rs * g1[2], f[7] * rs * g1[3]}); }
        { const float rs = rsqrtf(ssk * (1.0f / 256) + 1e-6f);
            const f32x4 g0 = *(const f32x4*)(nkv + lane * 4); u32x2 o; o.x = cvt_pk_bf16(f0 * rs * g0[0], f1 * rs * g0[1]); o.y = cvt_pk_bf16(f2 * rs * g0[2], f3 * rs * g0[3]);
            *(u32x2*)(pr + 512 + lane * 4) = o; }
        if (lane < 32) {
            const unsigned lo = cvt_pk_bf16(x1 * c.x - x2 * c.y, 0.f), hi = cvt_pk_bf16(x1 * c.y + x2 * c.x, 0.f);
            kr[(size_t)t * 64 + lane] = (bf16_t)(lo & 0xffffu); kr[(size_t)t * 64 + 32 + lane] = (bf16_t)(hi & 0xffffu); }
        { const f32x4 m4 = *(const f32x4*)(mu + col);
            float c4[4] = {bflo(cw.x), bfhi(cw.x), bflo(cw.y), bfhi(cw.y)}; const float p4[4] = {bflo(pw.x), bfhi(pw.x), bflo(pw.y), bfhi(pw.y)};
#pragma unroll
            for (int i = 0; i < 4; ++i) { float p = c4[i] + (p4[i] - c4[i]) * m4[i];
                if (lane < 16) p = 1.0f - 2.0f * __builtin_amdgcn_rcpf(__expf(2.0f * p) + 1.0f); else if (lane >= 32) p = sigmoidf_(p);
                c4[i] = p; }
            u32x2 o; o.x = cvt_pk_bf16(c4[0], c4[1]); o.y = cvt_pk_bf16(c4[2], c4[3]); *(u32x2*)(lin + (size_t)t * 256 + lane * 4) = o; }
    }
}

template <int DQK, int D1, int DV, bool MLA, int NQ>
DEVINL void attn_block(LAS unsigned char* lds, const bf16_t* q, int ldq, const bf16_t* k1, int ld1, const bf16_t* k2, int ld2,
                       const bf16_t* vt, int ldv, bf16_t* o, int ldo, int nt, int qtile0, const f32x2* cs, float sc) {
    constexpr int KS = DQK * 2 + 16, VS = 144, BUF = 64 * KS + DV * VS, NKS = DQK / 32, NDB = DV / 16;
    constexpr int NC1 = D1 / 64, D2 = DQK - D1, NCV = DV / 64, CPR1 = D1 / 8;
    const int tid = opaque_tid(), wid = tid >> 6, lane = tid & 63, fr = lane & 15, fq = lane >> 4;
    const int jmax = MLA ? qtile0 + ((wid * 16 * NQ) >> 6) : nt - 1;
    bf16x8 qf[NQ][NKS];
#pragma unroll
    for (int qi = 0; qi < NQ; ++qi) { const int row = wid * 16 * NQ + qi * 16 + fr; const bf16_t* qrow = q + (size_t)row * ldq + fq * 8;
#pragma unroll
        for (int ks = 0; ks < NKS; ++ks) qf[qi][ks] = __builtin_nontemporal_load((const bf16x8*)(qrow + ks * 32));
        if (MLA) {
            const f32x2* c = cs + (size_t)row * 32 + fq * 8;
            float x1[8], x2[8]; unpack8(__builtin_bit_cast(u32x4, qf[qi][4]), x1); unpack8(__builtin_bit_cast(u32x4, qf[qi][5]), x2);
            float n1[8], n2[8];
#pragma unroll
            for (int i = 0; i < 8; ++i) { const f32x2 ci = c[i]; n1[i] = x1[i] * ci.x - x2[i] * ci.y; n2[i] = x1[i] * ci.y + x2[i] * ci.x; }
            u32x4 w1, w2; w1.x = cvt_pk_bf16(n1[0], n1[1]); w1.y = cvt_pk_bf16(n1[2], n1[3]); w1.z = cvt_pk_bf16(n1[4], n1[5]); w1.w = cvt_pk_bf16(n1[6], n1[7]);
            w2.x = cvt_pk_bf16(n2[0], n2[1]); w2.y = cvt_pk_bf16(n2[2], n2[3]); w2.z = cvt_pk_bf16(n2[4], n2[5]); w2.w = cvt_pk_bf16(n2[6], n2[7]);
            qf[qi][4] = __builtin_bit_cast(bf16x8, w1); qf[qi][5] = __builtin_bit_cast(bf16x8, w2);
        } }
    f32x4 acc[NQ][NDB];
#pragma unroll
    for (int qi = 0; qi < NQ; ++qi)
#pragma unroll
        for (int i = 0; i < NDB; ++i) acc[qi][i] = (f32x4){0.f, 0.f, 0.f, 0.f};
    float mrun[NQ], lrun[NQ];
#pragma unroll
    for (int qi = 0; qi < NQ; ++qi) { mrun[qi] = -INFINITY; lrun[qi] = 0.f; }
    u32x4 r1[NC1], r2, rv[NCV];
    auto gload = [&](int key0) {
#pragma unroll
        for (int i = 0; i < NC1; ++i) { const int c = tid + i * 512, row = c / CPR1, cc = c % CPR1; r1[i] = *(const u32x4*)(k1 + (size_t)(key0 + row) * ld1 + cc * 8); }
        if (D2 > 0) { const int row = tid >> 3, cc = tid & 7; r2 = *(const u32x4*)(k2 + (size_t)(key0 + row) * ld2 + cc * 8); }
#pragma unroll
        for (int i = 0; i < NCV; ++i) { const int c = tid + i * 512, row = c >> 3, cc = c & 7; rv[i] = *(const u32x4*)(vt + (size_t)row * ldv + key0 + cc * 8); }
    };
    auto lstore = [&](LAS unsigned char* b) {
#pragma unroll
        for (int i = 0; i < NC1; ++i) { const int c = tid + i * 512, row = c / CPR1, cc = c % CPR1; *(LAS u32x4*)(b + row * KS + cc * 16) = r1[i]; }
        if (D2 > 0) { const int row = tid >> 3, cc = tid & 7; *(LAS u32x4*)(b + row * KS + D1 * 2 + cc * 16) = r2; }
#pragma unroll
        for (int i = 0; i < NCV; ++i) { const int c = tid + i * 512, row = c >> 3, cc = c & 7; *(LAS u32x4*)(b + 64 * KS + row * VS + cc * 16) = rv[i]; }
    };
    gload(0); lstore(lds); __syncthreads();
    for (int j = 0; j < nt; ++j) {
        LAS unsigned char* cb = lds + (j & 1) * BUF;
        if (j + 1 < nt) gload((j + 1) * 64);
        if (j <= jmax) {
            f32x4 s[NQ][4];
#pragma unroll
            for (int kb = 0; kb < 4; ++kb) {
#pragma unroll
                for (int qi = 0; qi < NQ; ++qi) s[qi][kb] = (f32x4){0.f, 0.f, 0.f, 0.f};
#pragma unroll
                for (int ks = 0; ks < NKS; ++ks) { const bf16x8 a = *(const LAS bf16x8*)(cb + (kb * 16 + fr) * KS + ks * 64 + fq * 16);
#pragma unroll
                    for (int qi = 0; qi < NQ; ++qi) s[qi][kb] = __builtin_amdgcn_mfma_f32_16x16x32_bf16(a, qf[qi][ks], s[qi][kb], 0, 0, 0); } }
            bf16x8 pf[NQ][2];
#pragma unroll
            for (int qi = 0; qi < NQ; ++qi) {
                float mx = s[qi][0][0];
#pragma unroll
                for (int kb = 0; kb < 4; ++kb)
#pragma unroll
                    for (int i = 0; i < 4; ++i) mx = fmaxf(mx, s[qi][kb][i]);
                mx = fmaxf(mx, __shfl_xor(mx, 16)); mx = fmaxf(mx, __shfl_xor(mx, 32));
                const float mnew = fmaxf(mrun[qi], mx * sc), alpha = __builtin_amdgcn_exp2f(mrun[qi] - mnew);
                mrun[qi] = mnew; float ls = 0.f;
#pragma unroll
                for (int kb = 0; kb < 4; ++kb)
#pragma unroll
                    for (int i = 0; i < 4; ++i) { const float p = __builtin_amdgcn_exp2f(s[qi][kb][i] * sc - mnew); s[qi][kb][i] = p; ls += p; }
                lrun[qi] = lrun[qi] * alpha + ls;
#pragma unroll
                for (int i = 0; i < NDB; ++i) acc[qi][i] *= alpha;
#pragma unroll
                for (int ks = 0; ks < 2; ++ks) { u32x4 pw; pw.x = cvt_pk_bf16(s[qi][2 * ks][0], s[qi][2 * ks][1]); pw.y = cvt_pk_bf16(s[qi][2 * ks][2], s[qi][2 * ks][3]); pw.z = cvt_pk_bf16(s[qi][2 * ks + 1][0], s[qi][2 * ks + 1][1]); pw.w = cvt_pk_bf16(s[qi][2 * ks + 1][2], s[qi][2 * ks + 1][3]);
                    pf[qi][ks] = __builtin_bit_cast(bf16x8, pw); }
            }
#pragma unroll
            for (int ks = 0; ks < 2; ++ks)
#pragma unroll
                for (int db = 0; db < NDB; ++db) { const LAS unsigned char* vp = cb + 64 * KS + (db * 16 + fr) * VS + (32 * ks + 4 * fq) * 2;
                    const u32x2 lo = *(const LAS u32x2*)vp, hi = *(const LAS u32x2*)(vp + 32);
                    const bf16x8 a = __builtin_bit_cast(bf16x8, (u32x4){lo.x, lo.y, hi.x, hi.y});
#pragma unroll
                    for (int qi = 0; qi < NQ; ++qi) acc[qi][db] = __builtin_amdgcn_mfma_f32_16x16x32_bf16(a, pf[qi][ks], acc[qi][db], 0, 0, 0); }
        }
        if (j + 1 < nt) lstore(lds + ((j + 1) & 1) * BUF);
        __syncthreads();
    }
#pragma unroll
    for (int qi = 0; qi < NQ; ++qi) {
        float l = lrun[qi]; l += __shfl_xor(l, 16); l += __shfl_xor(l, 32);
        const float inv = 1.0f / l;
        bf16_t* orow = o + (size_t)(wid * 16 * NQ + qi * 16 + fr) * ldo + 4 * fq;
#pragma unroll
        for (int db = 0; db < NDB; ++db) { u32x2 w; w.x = cvt_pk_bf16(acc[qi][db][0] * inv, acc[qi][db][1] * inv); w.y = cvt_pk_bf16(acc[qi][db][2] * inv, acc[qi][db][3] * inv); *(u32x2*)(orow + db * 16) = w; }
    }
}

DEVINL void mla_attention(LAS unsigned char* lds, const bf16_t* q, const bf16_t* kn, const bf16_t* kr, const bf16_t* vt, bf16_t* o, const f32x2* cs) {
    const int c = blockIdx.x, x = c & 7, r = c >> 3;
    const float sc = 0.07216878364870322f * 1.4426950408889634f;
    for (int i = 0; (i * (int)gridDim.x + c) < 512 && i < 64; ++i) {
        int bh, pair;
        if (gridDim.x == 256) { bh = i * 64 + x * 8 + (r >> 2); pair = r & 3; } else { const int uu = i * gridDim.x + c; bh = uu >> 2; pair = uu & 3; }
        const int b = bh >> 3, h = bh & 7;
#pragma unroll 1
        for (int half = 0; half < 2; ++half) {
            const int qb = half == 0 ? pair : 7 - pair, q0 = qb * 256; const size_t t0 = (size_t)b * SEQ;
            attn_block<192, 128, 128, true, 2>(lds, q + (t0 + q0) * 1536 + h * 192, 1536, kn + t0 * 1024 + h * 128, 1024, kr + t0 * 64, 64,
                                               vt + (size_t)(h * 128) * T + t0, T, o + (t0 + q0) * 1024 + h * 128, 1024, 4 * qb + 4, 4 * qb, cs + (t0 + q0) * 32, sc);
        }
    }
}
DEVINL void mem_attention(LAS unsigned char* lds, const bf16_t* qx, const bf16_t* km, const bf16_t* vtm, bf16_t* o) {
    const int c = blockIdx.x, x = c & 7, r = c >> 3;
    const float sc = 0.0625f * 1.4426950408889634f;
    for (int i = 0; (i * (int)gridDim.x + c) < 1024 && i < 64; ++i) {
        int bh, qb;
        if (gridDim.x == 256) { bh = i * 16 + x * 2 + (r >> 4); qb = r & 15; } else { const int uu = i * gridDim.x + c; bh = uu >> 4; qb = uu & 15; }
        const int b = bh >> 2, h = bh & 3; const size_t t0 = (size_t)b * SEQ + qb * 128;
        attn_block<256, 256, 256, false, 1>(lds, qx + t0 * 1024 + h * 256, 1024, km + (size_t)(b * 256) * 1024 + h * 256, 1024, nullptr, 0,
                                            vtm + (size_t)(h * 256) * NMEMT + b * 256, NMEMT, o + t0 * 1024 + h * 256, 1024, 4, 0, nullptr, sc);
    }
}

constexpr int CH = 32;
DEVINL void rwkv_scan(LAS unsigned char* lds, const bf16_t* Prwkv, const bf16_t* Aa, const bf16_t* Gg, const bf16_t* Uu, const float* w0v, const float* a0v, const float* mu,
                      const float* k_k, const float* k_a, const float* r_k, const float* lnx_w, const float* lnx_b, bf16_t* out) {
    LAS float* IN = (LAS float*)lds;
    LAS float* OUT = (LAS float*)(lds + 2 * 6 * CH * 64 * 4);
    LAS float* SC = (LAS float*)(lds + 2 * 6 * CH * 64 * 4 + 2 * CH * 64 * 4);
    const int tid = opaque_tid(), wid = tid >> 6, lane = tid & 63;
    for (int bh = blockIdx.x; bh < NB * 16; bh += gridDim.x) {
        const int b = bh >> 4, h = bh & 15; const size_t t0 = (size_t)b * SEQ;
        const int ht = tid - 256, hstep = ht >> 3, hc = (ht & 7) * 8;
        u32x4 qcr, qck, qcv, qpr, qpk, qpv, qa, qu, gq;
        auto load_raw = [&](int cc) {
            const int s = cc * CH + hstep; const size_t t = t0 + s; const int cb = h * 64 + hc;
            const bf16_t* pc = Prwkv + t * 3328 + cb;
            qcr = *(const u32x4*)(pc); qck = *(const u32x4*)(pc + 1024); qcv = *(const u32x4*)(pc + 2048);
            qpr = (u32x4){0u, 0u, 0u, 0u}; qpk = qpr; qpv = qpr;
            if (s > 0) { qpr = *(const u32x4*)(pc - 3328); qpk = *(const u32x4*)(pc - 3328 + 1024); qpv = *(const u32x4*)(pc - 3328 + 2048); }
            qa = __builtin_nontemporal_load((const u32x4*)(Aa + t * 1024 + cb)); qu = __builtin_nontemporal_load((const u32x4*)(Uu + t * 1024 + cb));
        };
        auto load_gate = [&](int cc) { gq = __builtin_nontemporal_load((const u32x4*)(Gg + (t0 + cc * CH + hstep) * 1024 + h * 64 + hc)); };
        auto prep = [&](int cc) {
            const int cb = h * 64 + hc;
            LAS float* base = IN + (cc & 1) * (6 * CH * 64) + hstep * 64 + hc;
            float rr[8], tmp[8], prv[8], av[8], kk[8];
            unpack8(qcr, rr); unpack8(qpr, prv);
#pragma unroll
            for (int i = 0; i < 8; ++i) rr[i] += (prv[i] - rr[i]) * mu[cb + i];
            unpack8(qcv, tmp); unpack8(qpv, prv);
#pragma unroll
            for (int i = 0; i < 8; ++i) tmp[i] += (prv[i] - tmp[i]) * mu[2048 + cb + i];
            *(LAS f32x4*)(base + 3 * CH * 64) = (f32x4){tmp[0], tmp[1], tmp[2], tmp[3]}; *(LAS f32x4*)(base + 3 * CH * 64 + 4) = (f32x4){tmp[4], tmp[5], tmp[6], tmp[7]};
            asm volatile("" ::: "memory");
            unpack8(qu, tmp);
#pragma unroll
            for (int i = 0; i < 8; ++i) { tmp[i] = __expf(-0.60653066f * sigmoidf_(tmp[i] + w0v[cb + i])); prv[i] = tmp[i] * rr[i]; }
            *(LAS f32x4*)(base + 1 * CH * 64) = (f32x4){tmp[0], tmp[1], tmp[2], tmp[3]}; *(LAS f32x4*)(base + 1 * CH * 64 + 4) = (f32x4){tmp[4], tmp[5], tmp[6], tmp[7]};
            *(LAS f32x4*)(base + 0 * CH * 64) = (f32x4){prv[0], prv[1], prv[2], prv[3]}; *(LAS f32x4*)(base + 0 * CH * 64 + 4) = (f32x4){prv[4], prv[5], prv[6], prv[7]};
            asm volatile("" ::: "memory");
            unpack8(qa, av);
#pragma unroll
            for (int i = 0; i < 8; ++i) av[i] = sigmoidf_(av[i] + a0v[cb + i]);
            unpack8(qck, tmp); unpack8(qpk, prv); float ss = 0.f, pkr = 0.f, pbs = 0.f, pbr = 0.f;
#pragma unroll
            for (int i = 0; i < 8; ++i) { const float kx = tmp[i] + (prv[i] - tmp[i]) * mu[1024 + cb + i]; kk[i] = kx * k_k[cb + i]; ss += kk[i] * kk[i]; tmp[i] = kx * (1.0f + (av[i] - 1.0f) * k_a[cb + i]);
                const float rk = rr[i] * tmp[i]; pkr += rk; pbs += rk * r_k[cb + i]; }
            *(LAS f32x4*)(base + 2 * CH * 64) = (f32x4){tmp[0], tmp[1], tmp[2], tmp[3]}; *(LAS f32x4*)(base + 2 * CH * 64 + 4) = (f32x4){tmp[4], tmp[5], tmp[6], tmp[7]};
            ss = sum8(ss); const float rn = 1.0f / fmaxf(sqrtf(ss), 1e-12f);
#pragma unroll
            for (int i = 0; i < 8; ++i) kk[i] *= rn;
            *(LAS f32x4*)(base + 4 * CH * 64) = (f32x4){kk[0], kk[1], kk[2], kk[3]}; *(LAS f32x4*)(base + 4 * CH * 64 + 4) = (f32x4){kk[4], kk[5], kk[6], kk[7]};
#pragma unroll
            for (int i = 0; i < 8; ++i) { kk[i] *= av[i]; pbr += kk[i] * rr[i]; }
            *(LAS f32x4*)(base + 5 * CH * 64) = (f32x4){kk[0], kk[1], kk[2], kk[3]}; *(LAS f32x4*)(base + 5 * CH * 64 + 4) = (f32x4){kk[4], kk[5], kk[6], kk[7]};
            pbr = sum8(pbr); pkr = sum8(pkr); pbs = sum8(pbs);
            if ((ht & 7) == 0) { LAS float* sc = SC + (cc & 1) * (3 * CH) + hstep; sc[0] = pbr; sc[CH] = pkr; sc[2 * CH] = pbs; }
        };
        auto post = [&](int cc) {
            const int s = cc * CH + hstep; const size_t t = t0 + s;
            const LAS float* ib = IN + (cc & 1) * (6 * CH * 64) + hstep * 64 + hc; const LAS float* ob = OUT + (cc & 1) * (CH * 64) + hstep * 64 + hc;
            float ov[8], vv[8], gv[8];
            { const f32x4 a0 = *(const LAS f32x4*)ob, a1 = *(const LAS f32x4*)(ob + 4); ov[0] = a0[0]; ov[1] = a0[1]; ov[2] = a0[2]; ov[3] = a0[3]; ov[4] = a1[0]; ov[5] = a1[1]; ov[6] = a1[2]; ov[7] = a1[3]; }
            { const f32x4 a0 = *(const LAS f32x4*)(ib + 3 * CH * 64), a1 = *(const LAS f32x4*)(ib + 3 * CH * 64 + 4); vv[0] = a0[0]; vv[1] = a0[1]; vv[2] = a0[2]; vv[3] = a0[3]; vv[4] = a1[0]; vv[5] = a1[1]; vv[6] = a1[2]; vv[7] = a1[3]; }
            const float bs = SC[(cc & 1) * (3 * CH) + 2 * CH + hstep];
            unpack8(gq, gv);
            float sm = 0.f;
#pragma unroll
            for (int i = 0; i < 8; ++i) sm += ov[i];
            sm = sum8(sm); const float mean = sm * (1.0f / 64); float vs = 0.f;
#pragma unroll
            for (int i = 0; i < 8; ++i) { const float d = ov[i] - mean; vs += d * d; }
            vs = sum8(vs); const float rs = rsqrtf(vs * (1.0f / 64) + 64e-5f);
            float res[8];
#pragma unroll
            for (int i = 0; i < 8; ++i) { const int cidx = h * 64 + hc + i; res[i] = ((ov[i] - mean) * rs * lnx_w[cidx] + lnx_b[cidx] + bs * vv[i]) * gv[i]; }
            store8(out + t * 1024 + h * 64 + hc, (f32x4){res[0], res[1], res[2], res[3]}, (f32x4){res[4], res[5], res[6], res[7]});
        };
        const int kp = (lane & 7) * 8, v0 = wid * 8 + (lane >> 3), v1 = v0 + 32;
        f32x2 st0[4], st1[4];
#pragma unroll
        for (int i = 0; i < 4; ++i) { st0[i] = (f32x2){0.f, 0.f}; st1[i] = (f32x2){0.f, 0.f}; }
        if (wid < 4) {
          __syncthreads();
          for (int cc = 0; cc < SEQ / CH; ++cc) {
            {
                const LAS float* ib = IN + (cc & 1) * (6 * CH * 64); LAS float* ob = OUT + (cc & 1) * (CH * 64); const LAS float* sc_ = SC + (cc & 1) * (3 * CH);
                f32x4 Ka[2], Kb[2]; float Av0, Av1, Bv0, Bv1;
#define SCAN_LDK(X, X0, X1, s_) do { const LAS float* p_ = ib + (s_) * 64 + kp; \
                    X[0] = *(const LAS f32x4*)(p_ + 4 * CH * 64); X[1] = *(const LAS f32x4*)(p_ + 4 * CH * 64 + 4); \
                    X0 = ib[3 * CH * 64 + (s_) * 64 + v0]; X1 = ib[3 * CH * 64 + (s_) * 64 + v1]; } while (0)
#define SCAN_STEP(X, X0, X1, s_, PRE) do { const LAS float* p_ = ib + (s_) * 64 + kp; f32x4 Y[8]; \
                    Y[0] = *(const LAS f32x4*)(p_ + 0 * CH * 64); Y[1] = *(const LAS f32x4*)(p_ + 0 * CH * 64 + 4); \
                    Y[2] = *(const LAS f32x4*)(p_ + 1 * CH * 64); Y[3] = *(const LAS f32x4*)(p_ + 1 * CH * 64 + 4); \
                    Y[4] = *(const LAS f32x4*)(p_ + 5 * CH * 64); Y[5] = *(const LAS f32x4*)(p_ + 5 * CH * 64 + 4); \
                    Y[6] = *(const LAS f32x4*)(p_ + 2 * CH * 64); Y[7] = *(const LAS f32x4*)(p_ + 2 * CH * 64 + 4); \
                    const float br_ = sc_[(s_)], kr_ = sc_[CH + (s_)]; \
                    f32x2 kk_[4], wr_[4], w_[4], b_[4], k_[4]; \
                    _Pragma("unroll") for (int h2 = 0; h2 < 2; ++h2) { \
                        kk_[2 * h2] = (f32x2){X[h2][0], X[h2][1]}; kk_[2 * h2 + 1] = (f32x2){X[h2][2], X[h2][3]}; \
                        wr_[2 * h2] = (f32x2){Y[0 + h2][0], Y[0 + h2][1]}; wr_[2 * h2 + 1] = (f32x2){Y[0 + h2][2], Y[0 + h2][3]}; \
                        w_[2 * h2] = (f32x2){Y[2 + h2][0], Y[2 + h2][1]}; w_[2 * h2 + 1] = (f32x2){Y[2 + h2][2], Y[2 + h2][3]}; \
                        b_[2 * h2] = (f32x2){Y[4 + h2][0], Y[4 + h2][1]}; b_[2 * h2 + 1] = (f32x2){Y[4 + h2][2], Y[4 + h2][3]}; \
                        k_[2 * h2] = (f32x2){Y[6 + h2][0], Y[6 + h2][1]}; k_[2 * h2 + 1] = (f32x2){Y[6 + h2][2], Y[6 + h2][3]}; } \
                    const f32x2 d0 = (st0[0] * kk_[0] + st0[1] * kk_[1]) + (st0[2] * kk_[2] + st0[3] * kk_[3]); \
                    const f32x2 d1 = (st1[0] * kk_[0] + st1[1] * kk_[1]) + (st1[2] * kk_[2] + st1[3] * kk_[3]); \
                    const f32x2 e0 = (st0[0] * wr_[0] + st0[1] * wr_[1]) + (st0[2] * wr_[2] + st0[3] * wr_[3]); \
                    const f32x2 e1 = (st1[0] * wr_[0] + st1[1] * wr_[1]) + (st1[2] * wr_[2] + st1[3] * wr_[3]); \
                    const float sa0 = -sum8(d0.x + d0.y), sa1 = -sum8(d1.x + d1.y), q0_ = sum8(e0.x + e0.y), q1_ = sum8(e1.x + e1.y); \
                    const float xv0 = X0, xv1 = X1; \
                    PRE; \
                    _Pragma("unroll") for (int i = 0; i < 4; ++i) { \
                        st0[i] = st0[i] * w_[i] + (b_[i] * sa0 + k_[i] * xv0); \
                        st1[i] = st1[i] * w_[i] + (b_[i] * sa1 + k_[i] * xv1); } \
                    if ((lane & 7) == 0) { ob[(s_) * 64 + v0] = q0_ + sa0 * br_ + xv0 * kr_; ob[(s_) * 64 + v1] = q1_ + sa1 * br_ + xv1 * kr_; } } while (0)
                __builtin_amdgcn_s_setprio(2);
                SCAN_LDK(Ka, Av0, Av1, 0);
#pragma unroll 1
                for (int s = 0; s < CH; s += 2) {
                    SCAN_STEP(Ka, Av0, Av1, s, SCAN_LDK(Kb, Bv0, Bv1, s + 1));
                    const int sn = (s + 2 < CH) ? s + 2 : CH - 1;
                    SCAN_STEP(Kb, Bv0, Bv1, s + 1, SCAN_LDK(Ka, Av0, Av1, sn));
                }
                __builtin_amdgcn_s_setprio(0);
#undef SCAN_LDK
#undef SCAN_STEP
            }
            __syncthreads();
          }
        } else {
          load_raw(0); prep(0); load_raw(1); load_gate(0);
          __syncthreads();
          for (int cc = 0; cc < SEQ / CH; ++cc) {
            if (cc > 0) { post(cc - 1); load_gate(cc); }
            asm volatile("" ::: "memory");
            if (cc + 1 < SEQ / CH) prep(cc + 1);
            if (cc + 2 < SEQ / CH) load_raw(cc + 2);
            __syncthreads();
          }
          post(SEQ / CH - 1);
        }
        __syncthreads();
    }
}

#define XB_TMO      128
#define XB_XCNT(j)  (256  + 64 * (j))
#define XB_XSUB(j)  (1280 + 64 * (j))
#define XB_XGEN(j)  (2304 + 64 * (j))
#define XB_TOP      3328
#define XB_TOPGEN   3392
#define XCD_BAR_WORDS 3456
#define XB_SPIN_CAP (1u << 22)
DEVINL unsigned xb_ld(unsigned* p) { return __hip_atomic_load(p, __ATOMIC_RELAXED, __HIP_MEMORY_SCOPE_AGENT); }
DEVINL unsigned xb_add(unsigned* p, unsigned v) { return __hip_atomic_fetch_add(p, v, __ATOMIC_RELAXED, __HIP_MEMORY_SCOPE_AGENT); }
DEVINL unsigned xb_xcc_id() { return (unsigned)__builtin_amdgcn_s_getreg((3 << 11) | 20) & 0xFu; }
#define XB_SPIN(cond, bar) do { unsigned _sp = 0; while (cond) { __builtin_amdgcn_s_sleep(1); \
    if ((++_sp & 255u) == 0u) { if (xb_ld(&(bar)[XB_TMO])) break; if (_sp > XB_SPIN_CAP) { atomicAdd(&(bar)[XB_TMO], 1u); break; } } } } while (0)
struct XcdBarrier { unsigned* bar; unsigned x; volatile LAS unsigned* st; };
DEVINL XcdBarrier xcd_barrier_post(unsigned* bar, volatile LAS unsigned* st) {
    XcdBarrier b; b.bar = bar; b.x = xb_xcc_id(); b.st = st;
    if (threadIdx.x == 0) (void)xb_add(&bar[XB_XCNT(b.x)], 1u);
    return b;
}
DEVINL void xcd_barrier_complete(unsigned* bar, unsigned x, unsigned& nloc, unsigned& nx) {
    const unsigned G = gridDim.x * gridDim.y * gridDim.z;
    unsigned sum, cnt, mine, sp = 0u;
    for (;;) {
        sum = 0u; cnt = 0u; mine = 0u;
#pragma unroll
        for (unsigned j = 0; j < 16; ++j) { const unsigned c = xb_ld(&bar[XB_XCNT(j)]); sum += c; cnt += (c > 0u) ? 1u : 0u; mine = (j == x) ? c : mine; }
        if (sum == G) break;
        __builtin_amdgcn_s_sleep(1);
        if ((++sp & 255u) == 0u) { if (xb_ld(&bar[XB_TMO])) break; if (sp > XB_SPIN_CAP) { atomicAdd(&bar[XB_TMO], 1u); break; } }
    }
    nloc = mine > 0u ? mine : 1u; nx = cnt > 0u ? cnt : 1u;
}
DEVINL void xcd_barrier(const XcdBarrier& b) {
    asm volatile("s_waitcnt vmcnt(0)" ::: "memory");
    __syncthreads();
    if (threadIdx.x == 0) {
        unsigned* bar = b.bar;
        __builtin_amdgcn_s_waitcnt(0);
        unsigned nloc = b.st[0], nx = b.st[1];
        if (nloc == 0u) { xcd_barrier_complete(bar, b.x, nloc, nx); b.st[0] = nloc; b.st[1] = nx; }
        const unsigned old = xb_add(&bar[XB_XSUB(b.x)], 1u);
        const unsigned gen = old / nloc;
        if (old + 1u == (gen + 1u) * nloc) {
            __builtin_amdgcn_fence(__ATOMIC_RELEASE, "agent");
            asm volatile("s_waitcnt vmcnt(0)" ::: "memory");
            const unsigned og = xb_add(&bar[XB_TOP], 1u);
            const unsigned tg = og / nx;
            if (og + 1u == (tg + 1u) * nx) xb_add(&bar[XB_TOPGEN], 1u);
            else XB_SPIN(xb_ld(&bar[XB_TOPGEN]) == tg, bar);
            __builtin_amdgcn_fence(__ATOMIC_ACQUIRE, "agent");
            xb_add(&bar[XB_XGEN(b.x)], 1u);
            asm volatile("s_waitcnt vmcnt(0)" ::: "memory");
        } else {
            XB_SPIN(xb_ld(&bar[XB_XGEN(b.x)]) == gen, bar);
            __builtin_amdgcn_fence(__ATOMIC_ACQUIRE, "agent");
            asm volatile("s_waitcnt vmcnt(0)" ::: "memory");
        }
    }
    __syncthreads();
}

#define CG_BARRIER() do { \
    asm volatile("s_waitcnt vmcnt(0) lgkmcnt(0)" ::: "memory"); \
    grid.sync(); \
    if (threadIdx.x < 64) { __builtin_amdgcn_fence(__ATOMIC_ACQUIRE, "agent"); asm volatile("s_waitcnt vmcnt(0) lgkmcnt(0)" ::: "memory"); } \
    __syncthreads(); } while (0)
#define GRID_BARRIER() xcd_barrier(xb)
#define PHASE_END(n) GRID_BARRIER()

__global__ void __launch_bounds__(512) fwd_megakernel(Params p) {
    extern __shared__ __attribute__((aligned(16))) unsigned char shm[];
    LAS unsigned char* lds = (LAS unsigned char*)shm;
    cg::grid_group grid = cg::this_grid();
    __shared__ unsigned xb_words[4];
    if (threadIdx.x < 4) xb_words[threadIdx.x] = 0u;
    __syncthreads();
    const XcdBarrier xb = xcd_barrier_post((unsigned*)(p.ws + OFF_BAR), (volatile LAS unsigned*)xb_words);
    unsigned char* ws = p.ws;
    bf16_t* const Wi = (bf16_t*)(ws + OFF_WIN);
    bf16_t* const h = (bf16_t*)(ws + DY_H);
    const float* x_in = p.in[0];
    float* xres = p.out;

    { int rot = 0; conv_range<0, 20>(lds, p, rot); }
    zero_lora((bf16_t*)(ws + OFF_WLORA));
    rmsnorm_rows(x_in, p.in[3], h, T);
    rmsnorm_rows(p.in[1], p.in[32], (bf16_t*)(ws + DY_MEMN), NMEMT);
    cs_table(p.pos, (f32x2*)(ws + OFF_CS));
    CG_BARRIER();
    { EpiSwiGLU e; e.O = (bf16_t*)(ws + DY_ACT); run_gemm(lds, h, D, (bf16_t*)(ws + OFF_WFFGU), D, T, 11008, D, 0, e); }
    { EpiBf16 e; e.O = (bf16_t*)(ws + OFF_KMEM); e.ldc = 1024; run_gemm(lds, (bf16_t*)(ws + DY_MEMN), D, (bf16_t*)(ws + OFF_WCKVK), D, NMEMT, 1024, D, 128, e); }
    { EpiBf16 e; e.O = (bf16_t*)(ws + OFF_VTMEM); e.ldc = NMEMT; run_gemm(lds, (bf16_t*)(ws + OFF_WCKVV), D, (bf16_t*)(ws + DY_MEMN), D, 1024, NMEMT, D, 64, e); }
    PHASE_END(1);
    { EpiBf16 e; e.O = (bf16_t*)(ws + DY_YFFN); e.ldc = D; run_gemm(lds, (bf16_t*)(ws + DY_ACT), DFF, (bf16_t*)(ws + OFF_WFFD), DFF, T, D, DFF, 0, e); }
    PHASE_END(2);
    row_update((bf16_t*)(ws + DY_YFFN), x_in, xres, p.in[4], 0.5f, p.in[8], h);
    { int rot = 0; conv_range<20, 23>(lds, p, rot); }
    PHASE_END(3);
    { EpiIn e; e.Prwkv = (bf16_t*)(ws + DY_PRWKV); e.G = (bf16_t*)(ws + DY_GATES); e.Pmla = (bf16_t*)(ws + DY_PMLA); e.krraw = (float*)(ws + DY_KRRAW); e.bgate = p.in[11];
      run_gemm(lds, h, D, Wi, D, T, 8448, D, 0, e); }
    PHASE_END(4);
    mix_prep((bf16_t*)(ws + DY_PMLA), p.in[12], p.in[14], (float*)(ws + DY_KRRAW), (f32x2*)(ws + OFF_CS), (bf16_t*)(ws + OFF_KR), (bf16_t*)(ws + DY_PRWKV), p.in[17], (bf16_t*)(ws + DY_LIN));
    PHASE_END(5);
    { EpiBf16 e; e.O = (bf16_t*)(ws + DY_Q); e.ldc = 1536; run_gemm(lds, (bf16_t*)(ws + DY_PMLA), 768, (bf16_t*)(ws + OFF_WUQ), 512, T, 1536, 512, 0, e); }
    { EpiBf16 e; e.O = (bf16_t*)(ws + DY_KN); e.ldc = 1024; run_gemm(lds, (bf16_t*)(ws + DY_PMLA) + 512, 768, (bf16_t*)(ws + OFF_WUKVK), 256, T, 1024, 256, 0, e); }
    { EpiBf16 e; e.O = (bf16_t*)(ws + DY_VT); e.ldc = T; run_gemm(lds, (bf16_t*)(ws + OFF_WUKVV), 256, (bf16_t*)(ws + DY_PMLA) + 512, 768, 1024, T, 256, 0, e); }
    PHASE_END(6);
    mla_attention(lds, (bf16_t*)(ws + DY_Q), (bf16_t*)(ws + DY_KN), (bf16_t*)(ws + OFF_KR), (bf16_t*)(ws + DY_VT), (bf16_t*)(ws + DY_OMLA), (f32x2*)(ws + OFF_CS));
    PHASE_END(7);
    { EpiLora<0> e; e.O = (bf16_t*)(ws + DY_U); e.bias = p.in[18]; run_gemm(lds, (bf16_t*)(ws + DY_LIN), 256, (bf16_t*)(ws + OFF_WLORA), 256, T, 1024, 256, 0, e); }
    { EpiLora<1> e; e.O = (bf16_t*)(ws + DY_A); e.bias = p.in[20]; run_gemm(lds, (bf16_t*)(ws + DY_LIN), 256, (bf16_t*)(ws + OFF_WLORA) + (size_t)1024 * 256, 256, T, 1024, 256, 0, e); }
    { EpiLora<2> e; e.O = (bf16_t*)(ws + DY_G); e.bias = nullptr; run_gemm(lds, (bf16_t*)(ws + DY_LIN), 256, (bf16_t*)(ws + OFF_WLORA) + (size_t)2048 * 256, 256, T, 1024, 256, 0, e); }
    PHASE_END(8);
    rwkv_scan(lds, (bf16_t*)(ws + DY_PRWKV), (bf16_t*)(ws + DY_A), (bf16_t*)(ws + DY_G), (bf16_t*)(ws + DY_U), p.in[18], p.in[20], p.in[17], p.in[23], p.in[24], p.in[25], p.in[26], p.in[27], (bf16_t*)(ws + DY_ORWKV));
    PHASE_END(9);
    { EpiGate<0> e; e.G = (bf16_t*)(ws + DY_GATES); e.Mg = (bf16_t*)(ws + DY_MERGED); run_gemm(lds, (bf16_t*)(ws + DY_OMLA), 1024, (bf16_t*)(ws + OFF_WOA), 1024, T, D, 1024, 0, e); }
    PHASE_END(10);
    { EpiGate<1> e; e.G = (bf16_t*)(ws + DY_GATES) + 2048; e.Mg = (bf16_t*)(ws + DY_MERGED); run_gemm(lds, (bf16_t*)(ws + DY_ORWKV), 1024, (bf16_t*)(ws + OFF_WOB), 1024, T, D, 1024, 0, e); }
    PHASE_END(11);
    { EpiBf16 e; e.O = (bf16_t*)(ws + DY_Y); e.ldc = D; run_gemm(lds, (bf16_t*)(ws + DY_MERGED), D, (bf16_t*)(ws + OFF_WO), D, T, D, D, 0, e); }
    PHASE_END(12);
    row_update((bf16_t*)(ws + DY_Y), xres, xres, p.in[9], 1.0f, p.in[30], h);
    PHASE_END(13);
    { EpiBf16 e; e.O = (bf16_t*)(ws + DY_QX); e.ldc = 1024; run_gemm(lds, h, D, (bf16_t*)(ws + OFF_WCQ), D, T, 1024, D, 0, e); }
    PHASE_END(14);
    mem_attention(lds, (bf16_t*)(ws + DY_QX), (bf16_t*)(ws + OFF_KMEM), (bf16_t*)(ws + OFF_VTMEM), (bf16_t*)(ws + DY_OX));
    PHASE_END(15);
    { EpiBf16 e; e.O = (bf16_t*)(ws + DY_Y); e.ldc = D; run_gemm(lds, (bf16_t*)(ws + DY_OX), 1024, (bf16_t*)(ws + OFF_WCO), 1024, T, D, 1024, 0, e); }
    PHASE_END(16);
    row_update((bf16_t*)(ws + DY_Y), xres, xres, p.in[31], 1.0f, p.in[36], h);
    PHASE_END(17);
    { EpiSwiGLU e; e.O = (bf16_t*)(ws + DY_ACT); run_gemm(lds, h, D, (bf16_t*)(ws + OFF_WFFGU), D, T, 11008, D, 0, e); }
    PHASE_END(18);
    { EpiBf16 e; e.O = (bf16_t*)(ws + DY_YFFN); e.ldc = D; run_gemm(lds, (bf16_t*)(ws + DY_ACT), DFF, (bf16_t*)(ws + OFF_WFFD), DFF, T, D, DFF, 0, e); }
    PHASE_END(19);
    row_update((bf16_t*)(ws + DY_YFFN), xres, xres, p.in[37], 0.5f, nullptr, nullptr);
}

static ConvJob mkjob(const float* src, bf16_t* dst, int K, int ldn, int c0, int ncols, int gs, int sstride, int dstride, int ldk) {
    ConvJob j; j.src = src; j.dst = dst; j.K = K; j.ldn = ldn; j.c0 = c0; j.ncols = ncols; j.gs = gs; j.sstride = sstride; j.dstride = dstride; j.ldk = ldk; return j;
}

extern "C" void kernel_launch(void* const* d_in, const int* in_sizes, int n_in, void* d_out, int out_size, void* d_ws, size_t ws_size, hipStream_t stream) {
    static int grid_blocks = 0;
    if (grid_blocks == 0) {
        if (n_in != 41 || out_size != T * D || ws_size < WS_NEED) { fprintf(stderr, "kernel_launch: unexpected shapes (n_in %d out %d ws %zu need %zu)\n", n_in, out_size, ws_size, (size_t)WS_NEED); grid_blocks = -1; return; }
        int dev = 0, cus = 0, per_cu = 0;
        hipGetDevice(&dev);
        hipDeviceGetAttribute(&cus, hipDeviceAttributeMultiprocessorCount, dev);
        if (hipFuncSetAttribute((const void*)fwd_megakernel, hipFuncAttributeMaxDynamicSharedMemorySize, LDS_BYTES) != hipSuccess) { fprintf(stderr, "kernel_launch: hipFuncSetAttribute failed\n"); grid_blocks = -1; return; }
        if (hipOccupancyMaxActiveBlocksPerMultiprocessor(&per_cu, (const void*)fwd_megakernel, 512, LDS_BYTES) != hipSuccess || per_cu < 1) { fprintf(stderr, "kernel_launch: occupancy query failed (%d)\n", per_cu); (void)hipGetLastError(); per_cu = 1; }
        grid_blocks = cus * per_cu;
    }
    if (grid_blocks < 0) return;
    Params p{};
    for (int i = 0; i < 41; ++i) p.in[i] = (const float*)d_in[i];
    p.pos = (const int*)d_in[2]; p.out = (float*)d_out; p.ws = (unsigned char*)d_ws;
    unsigned char* ws = (unsigned char*)d_ws;
    int n = 0;
    const float* w_in = (const float*)d_in[10];
    p.jobs[n++] = mkjob(w_in, (bf16_t*)(ws + OFF_WIN), 2048, 8256, 832, 3328, 3328, 0, 0, 2048);
    p.jobs[n++] = mkjob(w_in, (bf16_t*)(ws + OFF_WIN) + (size_t)3328 * 2048, 2048, 8256, 4160, 4096, 4096, 0, 0, 2048);
    p.jobs[n++] = mkjob(w_in, (bf16_t*)(ws + OFF_WIN) + (size_t)7424 * 2048, 2048, 8256, 0, 768, 768, 0, 0, 2048);
    p.jobs[n++] = mkjob(w_in, (bf16_t*)(ws + OFF_WIN) + (size_t)8192 * 2048, 2048, 8256, 768, 64, 64, 0, 0, 2048);
    p.jobs[n++] = mkjob((const float*)d_in[13], (bf16_t*)(ws + OFF_WUQ), 512, 1536, 0, 1536, 1536, 0, 0, 512);
    p.jobs[n++] = mkjob((const float*)d_in[15], (bf16_t*)(ws + OFF_WUKVK), 256, 2048, 0, 1024, 128, 256, 128, 256);
    p.jobs[n++] = mkjob((const float*)d_in[15], (bf16_t*)(ws + OFF_WUKVV), 256, 2048, 128, 1024, 128, 256, 128, 256);
    p.jobs[n++] = mkjob((const float*)d_in[19], (bf16_t*)(ws + OFF_WLORA), 64, 1024, 0, 1024, 1024, 0, 0, 256);
    p.jobs[n++] = mkjob((const float*)d_in[21], (bf16_t*)(ws + OFF_WLORA) + (size_t)1024 * 256 + 64, 64, 1024, 0, 1024, 1024, 0, 0, 256);
    p.jobs[n++] = mkjob((const float*)d_in[22], (bf16_t*)(ws + OFF_WLORA) + (size_t)2048 * 256 + 128, 128, 1024, 0, 1024, 1024, 0, 0, 256);
    p.jobs[n++] = mkjob((const float*)d_in[16], (bf16_t*)(ws + OFF_WOA), 1024, 2048, 0, 2048, 2048, 0, 0, 1024);
    p.jobs[n++] = mkjob((const float*)d_in[28], (bf16_t*)(ws + OFF_WOB), 1024, 2048, 0, 2048, 2048, 0, 0, 1024);
    p.jobs[n++] = mkjob((const float*)d_in[29], (bf16_t*)(ws + OFF_WO), 2048, 2048, 0, 2048, 2048, 0, 0, 2048);
    p.jobs[n++] = mkjob((const float*)d_in[33], (bf16_t*)(ws + OFF_WCQ), 2048, 1024, 0, 1024, 1024, 0, 0, 2048);
    p.jobs[n++] = mkjob((const float*)d_in[34], (bf16_t*)(ws + OFF_WCKVK), 2048, 2048, 0, 1024, 256, 512, 256, 2048);
    p.jobs[n++] = mkjob((const float*)d_in[34], (bf16_t*)(ws + OFF_WCKVV), 2048, 2048, 256, 1024, 256, 512, 256, 2048);
    p.jobs[n++] = mkjob((const float*)d_in[35], (bf16_t*)(ws + OFF_WCO), 1024, 2048, 0, 2048, 2048, 0, 0, 1024);
    p.jobs[n++] = mkjob((const float*)d_in[5], (bf16_t*)(ws + OFF_WFFGU), 2048, 5504, 0, 5504, 128, 128, 256, 2048);
    p.jobs[n++] = mkjob((const float*)d_in[6], (bf16_t*)(ws + OFF_WFFGU) + (size_t)128 * 2048, 2048, 5504, 0, 5504, 128, 128, 256, 2048);
    p.jobs[n++] = mkjob((const float*)d_in[7], (bf16_t*)(ws + OFF_WFFD), 5504, 2048, 0, 2048, 2048, 0, 0, 5504);
    p.jobs[n++] = mkjob((const float*)d_in[38], (bf16_t*)(ws + OFF_WFFGU), 2048, 5504, 0, 5504, 128, 128, 256, 2048);
    p.jobs[n++] = mkjob((const float*)d_in[39], (bf16_t*)(ws + OFF_WFFGU) + (size_t)128 * 2048, 2048, 5504, 0, 5504, 128, 128, 256, 2048);
    p.jobs[n++] = mkjob((const float*)d_in[40], (bf16_t*)(ws + OFF_WFFD), 5504, 2048, 0, 2048, 2048, 0, 0, 5504);
    if (hipMemsetAsync((unsigned char*)d_ws + OFF_BAR, 0, XCD_BAR_WORDS * sizeof(unsigned), stream) != hipSuccess) { fprintf(stderr, "kernel_launch: memset of barrier words failed\n"); return; }
    void* args[] = {&p};
    hipError_t e = hipLaunchCooperativeKernel((const void*)fwd_megakernel, dim3(grid_blocks), dim3(512), args, LDS_BYTES, stream);
    if (e != hipSuccess) fprintf(stderr, "cooperative launch failed: %s (grid %d)\n", hipGetErrorString(e), grid_blocks);
}
```
